# Optimizing an MI355X kernel written in HIP

```python
import math
import jax, jax.numpy as jnp
from jax import lax
import numpy as np

D_MODEL = 1024
BATCH = 4
SEQ = 8192
DEPTH = 2

N_MEM = 256
GRID_W = 64
EPS = 1e-6
Q_BLOCK = 128
NEG_INF = -1e30

D_FF = 2816

MLA_HEADS = 8
MLA_Q_LORA = 256
MLA_KV_LORA = 128
MLA_NOPE = 64
MLA_ROPE = 32
MLA_QK = MLA_NOPE + MLA_ROPE
MLA_V = 64
ROPE_THETA = 10000.0

SWA_HEADS = 4
SWA_KV_HEADS = 2
SWA_GROUP = SWA_HEADS // SWA_KV_HEADS
SWA_DH = 64
SWA_WINDOW = 128

NA_HEADS = 4
NA_DH = 64
NA_KR = 8
NA_KC = 16

MEM_HEADS = 4
MEM_DH = 64

MLA_IN = MLA_Q_LORA + MLA_KV_LORA + MLA_ROPE
SWA_IN = (SWA_HEADS + 2 * SWA_KV_HEADS) * SWA_DH
NA_IN = 3 * NA_HEADS * NA_DH
MIX_IN = MLA_IN + SWA_IN + NA_IN
MLA_OUT = MLA_HEADS * MLA_V
SWA_OUT = SWA_HEADS * SWA_DH
NA_OUT = NA_HEADS * NA_DH
MIX_WIDTH = MLA_OUT + SWA_OUT + NA_OUT

kernel_name = "hybrid_mla_swa_natten_macaron_encoder"


def rms_norm(x, g):
    xf = x.astype(jnp.float32)
    y = xf * lax.rsqrt(jnp.mean(xf * xf, axis=-1, keepdims=True) + EPS)
    return (y * g.astype(jnp.float32)).astype(x.dtype)


def softmax_f32(s, dtype):
    return jax.nn.softmax(s.astype(jnp.float32), axis=-1).astype(dtype)


def swiglu(x, w_in, w_out):
    g, u = jnp.split(x @ w_in, 2, axis=-1)
    return (jax.nn.silu(g) * u) @ w_out


def alibi_slopes(n):
    return 2.0 ** (-8.0 * jnp.arange(1, n + 1, dtype=jnp.float32) / n)


def rope_tables(S):
    inv = 1.0 / (ROPE_THETA ** (jnp.arange(0, MLA_ROPE, 2, dtype=jnp.float32) / MLA_ROPE))
    ang = jnp.arange(S, dtype=jnp.float32)[:, None] * inv[None, :]
    return jnp.cos(ang), jnp.sin(ang)


def apply_rope(x, cos, sin):
    x1, x2 = jnp.split(x, 2, axis=-1)
    c = cos[None, :, None, :].astype(x.dtype)
    s = sin[None, :, None, :].astype(x.dtype)
    return jnp.concatenate([x1 * c - x2 * s, x1 * s + x2 * c], axis=-1)


def mla_mixer(z, q_norm_g, w_uq, kv_norm_g, w_ukv, q_gain, k_gain):
    B, S, _ = z.shape
    cq, ckv, k_rope = jnp.split(z, [MLA_Q_LORA, MLA_Q_LORA + MLA_KV_LORA], axis=-1)
    q = (rms_norm(cq, q_norm_g) @ w_uq).reshape(B, S, MLA_HEADS, MLA_QK)
    kv = (rms_norm(ckv, kv_norm_g) @ w_ukv).reshape(B, S, MLA_HEADS, MLA_NOPE + MLA_V)
    k_nope, v = jnp.split(kv, [MLA_NOPE], axis=-1)
    k_rope = jnp.broadcast_to(k_rope[:, :, None, :], (B, S, MLA_HEADS, MLA_ROPE))
    k = jnp.concatenate([k_nope, k_rope], axis=-1)
    q = rms_norm(q, q_gain)
    k = rms_norm(k, k_gain)
    cos, sin = rope_tables(S)
    q = jnp.concatenate([q[..., :MLA_NOPE], apply_rope(q[..., MLA_NOPE:], cos, sin)], axis=-1)
    k = jnp.concatenate([k[..., :MLA_NOPE], apply_rope(k[..., MLA_NOPE:], cos, sin)], axis=-1)
    scale = MLA_QK ** -0.5
    nb = S // Q_BLOCK
    qb = q.reshape(B, nb, Q_BLOCK, MLA_HEADS, MLA_QK).transpose(1, 0, 2, 3, 4)

    def block(qi):
        s = jnp.einsum('bqhd,bkhd->bhqk', qi, k).astype(jnp.float32) * scale
        p = softmax_f32(s, v.dtype)
        return jnp.einsum('bhqk,bkhv->bqhv', p, v)

    o = lax.map(block, qb)
    return o.transpose(1, 0, 2, 3, 4).reshape(B, S, MLA_OUT)


def swa_mixer(z, q_gain, k_gain, sink):
    B, S, _ = z.shape
    q, k, v = jnp.split(z, [SWA_HEADS * SWA_DH, (SWA_HEADS + SWA_KV_HEADS) * SWA_DH], axis=-1)
    q = rms_norm(q.reshape(B, S, SWA_HEADS, SWA_DH), q_gain)
    k = rms_norm(k.reshape(B, S, SWA_KV_HEADS, SWA_DH), k_gain)
    v = v.reshape(B, S, SWA_KV_HEADS, SWA_DH)
    nb = S // Q_BLOCK
    qb = q.reshape(B, nb, Q_BLOCK, SWA_KV_HEADS, SWA_GROUP, SWA_DH)

    def band(t):
        tp = jnp.pad(t, ((0, 0), (Q_BLOCK, Q_BLOCK), (0, 0), (0, 0)))
        tp = tp.reshape(B, nb + 2, Q_BLOCK, SWA_KV_HEADS, SWA_DH)
        return jnp.concatenate([tp[:, :nb], tp[:, 1:nb + 1], tp[:, 2:]], axis=2)

    kb, vb = band(k), band(v)
    s = jnp.einsum('bnqhgd,bnkhd->bnhgqk', qb, kb).astype(jnp.float32) * (SWA_DH ** -0.5)
    qpos = jnp.arange(S, dtype=jnp.int32).reshape(nb, Q_BLOCK)
    kpos = jnp.arange(nb, dtype=jnp.int32)[:, None] * Q_BLOCK - Q_BLOCK + jnp.arange(3 * Q_BLOCK, dtype=jnp.int32)[None, :]
    dist = jnp.abs(qpos[:, :, None] - kpos[:, None, :])
    valid = (dist <= SWA_WINDOW) & (kpos[:, None, :] >= 0) & (kpos[:, None, :] < S)
    slopes = alibi_slopes(SWA_HEADS).reshape(SWA_KV_HEADS, SWA_GROUP)
    s = s - slopes[None, None, :, :, None, None] * dist.astype(jnp.float32)[None, :, None, None, :, :]
    s = jnp.where(valid[None, :, None, None, :, :], s, NEG_INF)
    sink_col = jnp.broadcast_to(
        sink.astype(jnp.float32).reshape(SWA_KV_HEADS, SWA_GROUP)[None, None, :, :, None, None],
        s.shape[:-1] + (1,))
    p = softmax_f32(jnp.concatenate([s, sink_col], axis=-1), v.dtype)[..., :-1]
    o = jnp.einsum('bnhgqk,bnkhd->bnqhgd', p, vb)
    return o.reshape(B, S, SWA_OUT)


def na_mixer(z, q_gain, k_gain, rel_bias):
    B, S, _ = z.shape
    rows = S // GRID_W
    kr = min(NA_KR, rows)
    q, k, v = jnp.split(z, 3, axis=-1)
    q = rms_norm(q.reshape(B, rows, GRID_W, NA_HEADS, NA_DH), q_gain)
    k = rms_norm(k.reshape(B, rows, GRID_W, NA_HEADS, NA_DH), k_gain)
    v = v.reshape(B, rows, GRID_W, NA_HEADS, NA_DH)
    cols = jnp.arange(GRID_W, dtype=jnp.int32)
    c0 = jnp.clip(cols - NA_KC // 2, 0, GRID_W - NA_KC)
    col_idx = c0[:, None] + jnp.arange(NA_KC, dtype=jnp.int32)[None, :]
    dc_idx = col_idx - cols[:, None] + (NA_KC - 1)
    scale = NA_DH ** -0.5

    def row_block(args):
        r, q_r = args
        r0 = jnp.clip(r - kr // 2, 0, rows - kr)
        k_rows = lax.dynamic_slice_in_dim(k, r0, kr, axis=1)
        v_rows = lax.dynamic_slice_in_dim(v, r0, kr, axis=1)
        k_win = k_rows[:, :, col_idx]
        v_win = v_rows[:, :, col_idx]
        s = jnp.einsum('bqhd,brqkhd->bhqrk', q_r, k_win).astype(jnp.float32) * scale
        dr_idx = r0 + jnp.arange(kr, dtype=jnp.int32) - r + (NA_KR - 1)
        bias = rel_bias[:, dr_idx][:, :, dc_idx]
        s = s + bias.transpose(0, 2, 1, 3).astype(jnp.float32)[None]
        p = softmax_f32(s.reshape(B, NA_HEADS, GRID_W, kr * NA_KC), v.dtype)
        p = p.reshape(B, NA_HEADS, GRID_W, kr, NA_KC)
        return jnp.einsum('bhqrk,brqkhd->bqhd', p, v_win)

    o = lax.map(row_block, (jnp.arange(rows, dtype=jnp.int32), q.transpose(1, 0, 2, 3, 4)))
    return o.transpose(1, 0, 2, 3, 4).reshape(B, S, NA_OUT)


def mem_xattn(h, mem, mem_g, w_q, w_kv, q_gain, k_gain, w_o):
    B, S, _ = h.shape
    M = mem.shape[1]
    m = rms_norm(mem, mem_g)
    q = rms_norm((h @ w_q).reshape(B, S, MEM_HEADS, MEM_DH), q_gain)
    kv = (m @ w_kv).reshape(B, M, 2, MEM_HEADS, MEM_DH)
    k = rms_norm(kv[:, :, 0], k_gain)
    v = kv[:, :, 1]
    s = jnp.einsum('bshd,bmhd->bhsm', q, k).astype(jnp.float32) * (MEM_DH ** -0.5)
    p = softmax_f32(s, v.dtype)
    o = jnp.einsum('bhsm,bmhd->bshd', p, v).reshape(B, S, MEM_HEADS * MEM_DH)
    return o @ w_o


def setup_inputs(seed: int = 0) -> dict:
    key = jax.random.key(seed)
    ks = iter(jax.random.split(key, 40))
    L = DEPTH

    def w(shape, fan_in):
        return jax.random.normal(next(ks), shape, jnp.float32) * (fan_in ** -0.5)

    def gain(shape):
        return 1.0 + 0.02 * jax.random.normal(next(ks), shape, jnp.float32)

    return {
        "x": jax.random.normal(next(ks), (BATCH, SEQ, D_MODEL), jnp.float32),
        "mem": jax.random.normal(next(ks), (BATCH, N_MEM, D_MODEL), jnp.float32),
        "ffn1_norm": gain((L, D_MODEL)),
        "ffn1_w_in": w((L, D_MODEL, 2 * D_FF), D_MODEL),
        "ffn1_w_out": w((L, D_FF, D_MODEL), D_FF),
        "mix_norm": gain((L, D_MODEL)),
        "w_mix_in": w((L, D_MODEL, MIX_IN), D_MODEL),
        "mla_q_norm": gain((L, MLA_Q_LORA)),
        "mla_w_uq": w((L, MLA_Q_LORA, MLA_HEADS * MLA_QK), MLA_Q_LORA),
        "mla_kv_norm": gain((L, MLA_KV_LORA)),
        "mla_w_ukv": w((L, MLA_KV_LORA, MLA_HEADS * (MLA_NOPE + MLA_V)), MLA_KV_LORA),
        "mla_q_gain": gain((L, MLA_QK)),
        "mla_k_gain": gain((L, MLA_QK)),
        "swa_q_gain": gain((L, SWA_DH)),
        "swa_k_gain": gain((L, SWA_DH)),
        "swa_sink": 0.5 * jax.random.normal(next(ks), (L, SWA_HEADS), jnp.float32),
        "na_q_gain": gain((L, NA_DH)),
        "na_k_gain": gain((L, NA_DH)),
        "na_rel_bias": 0.1 * jax.random.normal(next(ks), (L, NA_HEADS, 2 * NA_KR - 1, 2 * NA_KC - 1), jnp.float32),
        "grp_out_gain": gain((L, MIX_WIDTH)),
        "w_mix_out": w((L, MIX_WIDTH, D_MODEL), MIX_WIDTH),
        "mem_norm_x": gain((L, D_MODEL)),
        "mem_norm_m": gain((L, D_MODEL)),
        "mem_w_q": w((L, D_MODEL, MEM_HEADS * MEM_DH), D_MODEL),
        "mem_w_kv": w((L, D_MODEL, 2 * MEM_HEADS * MEM_DH), D_MODEL),
        "mem_q_gain": gain((L, MEM_DH)),
        "mem_k_gain": gain((L, MEM_DH)),
        "mem_w_o": w((L, MEM_HEADS * MEM_DH, D_MODEL), MEM_HEADS * MEM_DH),
        "ffn2_norm": gain((L, D_MODEL)),
        "ffn2_w_in": w((L, D_MODEL, 2 * D_FF), D_MODEL),
        "ffn2_w_out": w((L, D_FF, D_MODEL), D_FF),
        "block_norm": gain((L, D_MODEL)),
    }


def reference(x, mem, ffn1_norm, ffn1_w_in, ffn1_w_out, mix_norm, w_mix_in,
              mla_q_norm, mla_w_uq, mla_kv_norm, mla_w_ukv, mla_q_gain, mla_k_gain,
              swa_q_gain, swa_k_gain, swa_sink, na_q_gain, na_k_gain, na_rel_bias,
              grp_out_gain, w_mix_out, mem_norm_x, mem_norm_m, mem_w_q, mem_w_kv,
              mem_q_gain, mem_k_gain, mem_w_o, ffn2_norm, ffn2_w_in, ffn2_w_out,
              block_norm):
    for l in range(DEPTH):
        x = x + 0.5 * swiglu(rms_norm(x, ffn1_norm[l]), ffn1_w_in[l], ffn1_w_out[l])
        h = rms_norm(x, mix_norm[l])
        z = h @ w_mix_in[l]
        z_mla, z_swa, z_na = jnp.split(z, [MLA_IN, MLA_IN + SWA_IN], axis=-1)
        o_mla = mla_mixer(z_mla, mla_q_norm[l], mla_w_uq[l], mla_kv_norm[l], mla_w_ukv[l],
                          mla_q_gain[l], mla_k_gain[l])
        o_swa = swa_mixer(z_swa, swa_q_gain[l], swa_k_gain[l], swa_sink[l])
        o_na = na_mixer(z_na, na_q_gain[l], na_k_gain[l], na_rel_bias[l])
        g = grp_out_gain[l]
        o = jnp.concatenate([
            rms_norm(o_mla, g[:MLA_OUT]),
            rms_norm(o_swa, g[MLA_OUT:MLA_OUT + SWA_OUT]),
            rms_norm(o_na, g[MLA_OUT + SWA_OUT:]),
        ], axis=-1)
        x = x + o @ w_mix_out[l]
        x = x + mem_xattn(rms_norm(x, mem_norm_x[l]), mem, mem_norm_m[l], mem_w_q[l], mem_w_kv[l],
                          mem_q_gain[l], mem_k_gain[l], mem_w_o[l])
        x = x + 0.5 * swiglu(rms_norm(x, ffn2_norm[l]), ffn2_w_in[l], ffn2_w_out[l])
        x = rms_norm(x, block_norm[l])
    return x
```

```cpp
#include <hip/hip_runtime.h>
#include <hip/hip_cooperative_groups.h>
#include <cstdio>
#include <cstdint>
namespace cg = cooperative_groups;

#ifndef MK_PER_PHASE
#define MK_PER_PHASE 0
#endif

#ifndef PHMASK
#define PHMASK 0xffff
#endif
#define LAS __attribute__((address_space(3)))
#define DI __device__ __forceinline__
typedef unsigned short bf16_t;
typedef short bf16x8 __attribute__((ext_vector_type(8)));
typedef short s16x4 __attribute__((ext_vector_type(4)));
typedef float f32x2 __attribute__((ext_vector_type(2)));
typedef float f32x4 __attribute__((ext_vector_type(4)));
typedef float f32x16 __attribute__((ext_vector_type(16)));
typedef unsigned u32x2 __attribute__((ext_vector_type(2)));
typedef unsigned u32x4 __attribute__((ext_vector_type(4)));
typedef __bf16 bf16x2_t __attribute__((ext_vector_type(2)));

constexpr int BATCH = 4, SEQ = 8192, DM = 1024, NLAYER = 2, M = BATCH * SEQ, NMEM = 256, DFF = 2816;
constexpr int ZW = 1792;
constexpr float EPS = 1e-6f, LOG2E = 1.4426950408889634f;

constexpr size_t MiB = 1u << 20;
constexpr size_t WO_F1IN = 0, WO_F1OUT = WO_F1IN + (size_t)5632 * 1024, WO_MIX = WO_F1OUT + (size_t)1024 * 2816, WO_UQ = WO_MIX + (size_t)ZW * 1024,
                 WO_UKV = WO_UQ + (size_t)768 * 256, WO_MO = WO_UKV + (size_t)1024 * 128, WO_MQ = WO_MO + (size_t)1024 * 1024, WO_MKV = WO_MQ + (size_t)256 * 1024,
                 WO_MOUT = WO_MKV + (size_t)512 * 1024, WO_F2IN = WO_MOUT + (size_t)1024 * 256, WO_F2OUT = WO_F2IN + (size_t)5632 * 1024, W_LAYER = WO_F2OUT + (size_t)1024 * 2816;
static_assert(W_LAYER * 2 * NLAYER <= 84 * MiB, "weights fit");
constexpr size_t WS_W = 0, WS_XB = 84 * MiB, WS_SS = 148 * MiB, WS_SSZ = 150 * MiB, WS_MEMN = 152 * MiB, WS_MKV = 154 * MiB,
                 WS_H = 156 * MiB, WS_Z = 156 * MiB, WS_QR = 268 * MiB, WS_KVR = 332 * MiB, WS_KF = 396 * MiB,
                 WS_QM = 396 * MiB, WS_OM = 412 * MiB, WS_O = 444 * MiB, WS_END = 508 * MiB, WS_CTL = 83 * MiB, CTL_BYTES = 16384;
static_assert(WS_H + (size_t)M * DFF * 2 <= WS_KVR && WS_Z + (size_t)M * ZW * 2 <= WS_QR && WS_QR + (size_t)M * 768 * 2 <= WS_KVR, "ws map");

constexpr int LDS_BYTES = 147456;

DI float bf_lo(unsigned w) { return __uint_as_float(w << 16); }
DI float bf_hi(unsigned w) { return __uint_as_float(w & 0xffff0000u); }
DI unsigned pk2(float lo, float hi) { f32x2 v = {lo, hi}; bf16x2_t b = __builtin_convertvector(v, bf16x2_t); return __builtin_bit_cast(unsigned, b); }
DI float wave_sum(float v) {
#pragma unroll
    for (int o = 1; o < 64; o <<= 1) v += __shfl_xor(v, o);
    return v;
}
DI void unpack8(const u32x4 w, float (&f)[8]) {
    f[0] = bf_lo(w.x); f[1] = bf_hi(w.x); f[2] = bf_lo(w.y); f[3] = bf_hi(w.y); f[4] = bf_lo(w.z); f[5] = bf_hi(w.z); f[6] = bf_lo(w.w); f[7] = bf_hi(w.w);
}
DI u32x4 pack8(const float (&f)[8]) { u32x4 w; w.x = pk2(f[0], f[1]); w.y = pk2(f[2], f[3]); w.z = pk2(f[4], f[5]); w.w = pk2(f[6], f[7]); return w; }
DI void rope_cs(int pos, int i, float& c, float& s) {
    const float inv = exp2f(-(float)i * (13.287712379549449f / 16.0f));
    const float ang = (float)pos * inv;
    float rev = ang * 0.15915494309189535f; rev = rev - floorf(rev);
    s = __builtin_amdgcn_sinf(rev); c = __builtin_amdgcn_cosf(rev);
}

namespace pg8 {
constexpr int BM = 256, BK = 64, HALF = 128, HTB = HALF * BK * 2, STAGE_BYTES = 8 * HTB, NXCD = 8, WGM = 8;
DI int lds_byte(int r, int c) { const int st = (r >> 4) * 2 + (c >> 5), rr = r & 15, cc = c & 31, ob = rr * 64 + cc * 2; return st * 1024 + (ob ^ (((ob >> 9) & 1) << 5)); }
DI void stage_rc(int b, int& R, int& C) { const int st = b / 1024, sb = b % 1024, swz = sb ^ (((sb >> 9) & 1) << 5); R = (st >> 1) * 16 + swz / 64; C = (st & 1) * 32 + (swz % 64) / 2; }
DI int perm32(int rho) { const int n = rho >> 4, i = rho & 15; return 8 * (i >> 2) + 4 * n + (i & 3); }

struct Unit { int pm, pn; };
struct Gemm { const bf16_t* A; const bf16_t* Bt; int M, N, K, lda, ldb; };

struct StaticOrder {
    int nM, nN, nwg, G, c;
    DI void init(int M_, int N_, int G_, int c_) { nM = M_ / BM; nN = N_ / BM; nwg = nM * nN; G = G_; c = c_; }
    DI bool next(int i, Unit& u) const {
        const long L = (long)i * G + c; if (L >= nwg) return false;
        int wgid = (int)L; { const int q = nwg / NXCD, r = nwg % NXCD, xcd = wgid % NXCD, off = wgid / NXCD; wgid = (xcd < r ? xcd * (q + 1) : r * (q + 1) + (xcd - r) * q) + off; }
        const int nig = WGM * nN, gid = wgid / nig, fm = gid * WGM, gsz = (nM - fm) < WGM ? (nM - fm) : WGM;
        u.pm = fm + ((wgid % nig) % gsz); u.pn = (wgid % nig) / gsz; return true;
    }
};

DI float rstd_from16(const float* SS, size_t row, int fq) {
    const f32x4 v = *(const f32x4*)(SS + row * 16 + 4 * fq); float s = (v.x + v.y) + (v.z + v.w);
    s += __shfl_xor(s, 16); s += __shfl_xor(s, 32); return rsqrtf(s * (1.0f / 1024.0f) + EPS);
}
struct EpiSwiGLU {
    static constexpr bool PERM = true;
    bf16_t* H; const float* SS;
    DI void operator()(const f32x4 (&acc)[2][2][4][2], const Unit& u, int wr, int wc, int fr, int fq) const {
        const int col0 = u.pn * 128 + wc * 32 + 8 * fq;
#pragma unroll
        for (int ai = 0; ai < 2; ++ai)
#pragma unroll
            for (int m = 0; m < 4; ++m) {
                const size_t row = (size_t)u.pm * BM + ai * HALF + wr * 64 + m * 16 + fr;
                const float rs = rstd_from16(SS, row, fq);
                float hv[8];
#pragma unroll
                for (int n = 0; n < 2; ++n)
#pragma unroll
                    for (int e = 0; e < 4; ++e) {
                        const float g = acc[ai][0][m][n][e] * rs, uu = acc[ai][1][m][n][e] * rs;
                        const float sg = g * __builtin_amdgcn_rcpf(1.0f + __builtin_amdgcn_exp2f(-g * LOG2E));
                        hv[n * 4 + e] = sg * uu;
                    }
                *(u32x4*)(H + row * DFF + col0) = pack8(hv);
            }
    }
};
struct EpiResid {
    static constexpr bool PERM = true;
    bf16_t* xb; float* SS; float alpha;
    DI void operator()(const f32x4 (&acc)[2][2][4][2], const Unit& u, int wr, int wc, int fr, int fq) const {
        const int col0 = u.pn * BM + wc * 32 + 8 * fq;
#pragma unroll
        for (int ai = 0; ai < 2; ++ai) {
            u32x4 pre[4][2];
#pragma unroll
            for (int m = 0; m < 4; ++m)
#pragma unroll
                for (int bj = 0; bj < 2; ++bj)
                    pre[m][bj] = *(const u32x4*)(xb + ((size_t)u.pm * BM + ai * HALF + wr * 64 + m * 16 + fr) * DM + col0 + bj * HALF);
#pragma unroll
            for (int m = 0; m < 4; ++m) {
                const size_t row = (size_t)u.pm * BM + ai * HALF + wr * 64 + m * 16 + fr;
                float ss = 0.f;
#pragma unroll
                for (int bj = 0; bj < 2; ++bj) {
                    float v[8]; unpack8(pre[m][bj], v);
#pragma unroll
                    for (int n = 0; n < 2; ++n)
#pragma unroll
                        for (int e = 0; e < 4; ++e) { v[n * 4 + e] += acc[ai][bj][m][n][e] * alpha; ss += v[n * 4 + e] * v[n * 4 + e]; }
                    *(u32x4*)(xb + row * DM + col0 + bj * HALF) = pack8(v);
                }
                ss += __shfl_xor(ss, 16); ss += __shfl_xor(ss, 32);
                if (fq == 0) SS[row * 16 + u.pn * 4 + wc] = ss;
            }
        }
    }
};
template <int MODE> struct EpiScale {
    static constexpr bool PERM = true;
    bf16_t* O; int ldc; const float* ssrc; float* part;
    DI void operator()(const f32x4 (&acc)[2][2][4][2], const Unit& u, int wr, int wc, int fr, int fq) const {
        const int col0 = u.pn * BM + wc * 32 + 8 * fq;
#pragma unroll
        for (int ai = 0; ai < 2; ++ai)
#pragma unroll
            for (int m = 0; m < 4; ++m) {
                const size_t row = (size_t)u.pm * BM + ai * HALF + wr * 64 + m * 16 + fr;
                float rs = 1.0f;
                if constexpr (MODE == 1) rs = rstd_from16(ssrc, row, fq);
                if constexpr (MODE == 2) { const f32x2 v = *(const f32x2*)(ssrc + row * 16 + 2 * fq); float s = v.x + v.y; s += __shfl_xor(s, 16); s += __shfl_xor(s, 32); rs = rsqrtf(s * (1.0f / 256.0f) + EPS); }
                if constexpr (MODE == 3) { float s = ssrc[row * 16 + 8 + fq]; s += __shfl_xor(s, 16); s += __shfl_xor(s, 32); rs = rsqrtf(s * (1.0f / 128.0f) + EPS); }
#pragma unroll
                for (int bj = 0; bj < 2; ++bj) {
                    float v[8]; float ss = 0.f;
#pragma unroll
                    for (int n = 0; n < 2; ++n)
#pragma unroll
                        for (int e = 0; e < 4; ++e) { v[n * 4 + e] = acc[ai][bj][m][n][e] * rs; ss += v[n * 4 + e] * v[n * 4 + e]; }
                    *(u32x4*)(O + row * ldc + col0 + bj * HALF) = pack8(v);
                    if (part != nullptr && u.pn < 2) { ss += __shfl_xor(ss, 16); ss += __shfl_xor(ss, 32); if (fq == 0) part[row * 16 + u.pn * 8 + bj * 4 + wc] = ss; }
                }
            }
    }
};

template <class Epi>
DI void gemm_phase(LAS unsigned char* lds, const Gemm g, const StaticOrder& S, const Epi& E) {
    int tid = threadIdx.x; asm volatile("" : "+v"(tid));
    const int wid = __builtin_amdgcn_readfirstlane(tid >> 6), lane = tid & 63, wr = wid >> 2, wc = wid & 3, fr = lane & 15, fq = lane >> 4;
    int nt = g.K / BK; asm volatile("" : "+s"(nt));
    unsigned voffA[2], voffB[2];
#pragma unroll
    for (int i = 0; i < 2; ++i) { int R, C; stage_rc(tid * 16 + i * 8192, R, C); const int Rb = Epi::PERM ? ((R & ~31) + perm32(R & 31)) : R;
        voffA[i] = (unsigned)(R * g.lda + C) * 2u; voffB[i] = (unsigned)(Rb * g.ldb + C) * 2u; }
    const size_t kstep = (size_t)(BK * 2);
    const size_t hstepA = (size_t)HALF * g.lda * 2, hstepB = (size_t)HALF * g.ldb * 2;
    const size_t tstepA = 2 * hstepA, tstepB = 2 * hstepB;
    const unsigned ldsw = (unsigned)wid * 1024u;
    const int aoff = lds_byte(wr * 64 + fr, fq * 8), boff = lds_byte(wc * 32 + fr, fq * 8);
#define PG8_SA(b, h) (((b) * 2 + (h)) * HTB)
#define PG8_SB(b, h) ((4 + (b) * 2 + (h)) * HTB)
#define PG8_STAGE(bufoff, gbase, voff) do { _Pragma("unroll") for (int _i = 0; _i < 2; ++_i) \
        __builtin_amdgcn_global_load_lds((const unsigned*)((const char*)(gbase) + (voff)[_i]), (LAS unsigned*)(lds + (bufoff) + ldsw + _i * 8192), 16, 0, 0); } while (0)
#define PG8_LDA(dst, b, h) do { _Pragma("unroll") for (int m = 0; m < 4; ++m) _Pragma("unroll") for (int k = 0; k < 2; ++k) dst[m][k] = *(const LAS bf16x8*)(lds + PG8_SA(b, h) + aoff + m * 2048 + k * 1024); } while (0)
#define PG8_LDB(dst, b, h) do { _Pragma("unroll") for (int n = 0; n < 2; ++n) _Pragma("unroll") for (int k = 0; k < 2; ++k) dst[n][k] = *(const LAS bf16x8*)(lds + PG8_SB(b, h) + boff + n * 2048 + k * 1024); } while (0)
#define PG8_MMA(ai, bj, At, Bt) do { __builtin_amdgcn_s_setprio(1); _Pragma("unroll") for (int m = 0; m < 4; ++m) _Pragma("unroll") for (int n = 0; n < 2; ++n) _Pragma("unroll") for (int k = 0; k < 2; ++k) \
        acc[ai][bj][m][n] = __builtin_amdgcn_mfma_f32_16x16x32_bf16(Bt[n][k], At[m][k], acc[ai][bj][m][n], 0, 0, 0); __builtin_amdgcn_s_setprio(0); } while (0)
#define PG8_WAIT_V(n) asm volatile("s_waitcnt vmcnt(" #n ")" ::: "memory")
#define PG8_WAIT_L(n) asm volatile("s_waitcnt lgkmcnt(" #n ")" ::: "memory")
#define PG8_BAR __builtin_amdgcn_s_barrier()
#define PG8_SCHED __builtin_amdgcn_sched_barrier(0)
    Unit cur, nxt; int ui = 0;
    if (!S.next(0, cur)) return;
    f32x4 acc[2][2][4][2];
#pragma unroll
    for (int a = 0; a < 2; ++a)
#pragma unroll
        for (int b = 0; b < 2; ++b)
#pragma unroll
            for (int m = 0; m < 4; ++m)
#pragma unroll
                for (int n = 0; n < 2; ++n) acc[a][b][m][n] = (f32x4){0.f, 0.f, 0.f, 0.f};
    bf16x8 At[4][2], B0[2][2], B1[2][2];
    const char* cA = (const char*)g.A + (size_t)cur.pm * tstepA; const char* cB = (const char*)g.Bt + (size_t)cur.pn * tstepB;
    PG8_STAGE(PG8_SB(0, 0), cB, voffB); PG8_STAGE(PG8_SB(0, 1), cB + hstepB, voffB); PG8_STAGE(PG8_SA(0, 0), cA, voffA); PG8_STAGE(PG8_SA(0, 1), cA + hstepA, voffA);
    if (wr == 1) PG8_BAR;
    PG8_WAIT_V(2); PG8_BAR;
    PG8_STAGE(PG8_SB(1, 0), cB + kstep, voffB); PG8_STAGE(PG8_SA(1, 0), cA + kstep, voffA); PG8_STAGE(PG8_SB(1, 1), cB + hstepB + kstep, voffB);
    PG8_WAIT_V(6); PG8_BAR;
    for (;;) {
        const bool has_next = S.next(ui + 1, nxt);
        const char* nA = has_next ? (const char*)g.A + (size_t)nxt.pm * tstepA : cA; const char* nB = has_next ? (const char*)g.Bt + (size_t)nxt.pn * tstepB : cB;
        for (int t = 0; t < nt; t += 2) {
            const bool last = (t == nt - 2);
            const char* a1 = cA + (size_t)(t + 1) * kstep;
            const char* a2 = last ? nA : cA + (size_t)(t + 2) * kstep; const char* b2 = last ? nB : cB + (size_t)(t + 2) * kstep;
            const char* a3 = a2 + kstep; const char* b3 = b2 + kstep;
            PG8_LDB(B0, 0, 0); PG8_LDB(B1, 0, 1); PG8_SCHED; PG8_LDA(At, 0, 0); PG8_STAGE(PG8_SA(1, 1), a1 + hstepA, voffA);
            PG8_WAIT_V(8); PG8_WAIT_L(0); PG8_BAR; PG8_MMA(0, 0, At, B0); PG8_MMA(0, 1, At, B1); PG8_BAR; PG8_SCHED;
            PG8_LDA(At, 0, 1); PG8_STAGE(PG8_SB(0, 0), b2, voffB); PG8_STAGE(PG8_SB(0, 1), b2 + hstepB, voffB); PG8_STAGE(PG8_SA(0, 0), a2, voffA);
            PG8_WAIT_V(8); PG8_WAIT_L(0); PG8_BAR; PG8_MMA(1, 0, At, B0); PG8_MMA(1, 1, At, B1); PG8_BAR; PG8_SCHED;
            PG8_LDB(B0, 1, 0); PG8_LDB(B1, 1, 1); PG8_SCHED; PG8_LDA(At, 1, 0); PG8_STAGE(PG8_SA(0, 1), a2 + hstepA, voffA);
            PG8_WAIT_V(8); PG8_WAIT_L(0); PG8_BAR; PG8_MMA(0, 0, At, B0); PG8_MMA(0, 1, At, B1); PG8_BAR; PG8_SCHED;
            PG8_LDA(At, 1, 1); PG8_STAGE(PG8_SB(1, 0), b3, voffB); PG8_STAGE(PG8_SB(1, 1), b3 + hstepB, voffB); PG8_STAGE(PG8_SA(1, 0), a3, voffA);
            PG8_WAIT_V(8); PG8_WAIT_L(0); PG8_BAR; PG8_MMA(1, 0, At, B0); PG8_MMA(1, 1, At, B1); PG8_BAR; PG8_SCHED;
        }
        if (wr == 0) PG8_BAR;
        E(acc, cur, wr, wc, fr, fq);
        if (!has_next) break;
#pragma unroll
        for (int a = 0; a < 2; ++a)
#pragma unroll
            for (int b = 0; b < 2; ++b)
#pragma unroll
                for (int m = 0; m < 4; ++m)
#pragma unroll
                    for (int n = 0; n < 2; ++n) acc[a][b][m][n] = (f32x4){0.f, 0.f, 0.f, 0.f};
        cur = nxt; cA = nA; cB = nB; ++ui;
        if (wr == 1) PG8_BAR;
    }
    PG8_WAIT_V(0);
    PG8_BAR;
#undef PG8_SA
#undef PG8_SB
#undef PG8_STAGE
#undef PG8_LDA
#undef PG8_LDB
#undef PG8_MMA
#undef PG8_WAIT_V
#undef PG8_WAIT_L
#undef PG8_BAR
#undef PG8_SCHED
}
}

#define LDS_BAR() asm volatile("s_waitcnt lgkmcnt(0)\n\ts_barrier" ::: "memory")
enum { AT_MLA = 0, AT_SWA = 1, AT_NA = 2, AT_MEM = 3 };
struct AttnP {
    const bf16_t* Q; int ldq; int qoff;
    const bf16_t* K; const bf16_t* V;
    bf16_t* O; int ldo; int ooff;
    const float* qg; const float* kg;
    const float* sink; const float* relb;
};
DI float max3f(float a, float b, float c) { float r; asm("v_max3_f32 %0, %1, %2, %3" : "=v"(r) : "v"(a), "v"(b), "v"(c)); return r; }
DI int crow(int r, int hi) { return (r & 3) + 8 * (r >> 2) + 4 * hi; }
DI s16x4 vtr(LAS const unsigned char* p) { typedef short v4i16_t __attribute__((ext_vector_type(4))); return __builtin_bit_cast(s16x4, __builtin_amdgcn_ds_read_tr16_b64_v4i16((LAS v4i16_t*)p)); }

template <int T>
DI void attn_unit(const AttnP& P, const int b, const int h, const int qb, LAS unsigned char* lds) {
    constexpr int DQK = (T == AT_MLA) ? 96 : 64, NS = DQK / 16, KS = DQK * 2 + 16, VS = 192, KBUF = 64 * KS, VBUF = 64 * VS, KCH = DQK / 8;
    constexpr int KOFF = 0, VOFF = 2 * 13312, BOFF = VOFF + 2 * VBUF;
    int tid = threadIdx.x; asm volatile("" : "+v"(tid));
    const int lane = tid & 63, wid = __builtin_amdgcn_readfirstlane(tid >> 6), r32 = lane & 31, hi = lane >> 5;
    const int q0 = qb * 256, qpos = q0 + 32 * wid + r32;
    const size_t qrow = (size_t)b * SEQ + qpos;
    int nt, kbase0; int na_r = 0, na_r0w = 0, na_kr0 = 0;
    if constexpr (T == AT_MLA) { nt = SEQ / 64; kbase0 = 0; }
    else if constexpr (T == AT_MEM) { nt = NMEM / 64; kbase0 = 0; }
    else if constexpr (T == AT_SWA) { nt = 8; kbase0 = q0 - 128; }
    else { const int R0 = qb * 4; na_kr0 = min(max(R0 - 4, 0), 120); const int krl = min(max(R0 + 3 - 4, 0), 120) + 7; nt = krl - na_kr0 + 1; kbase0 = 64 * na_kr0;
           na_r = R0 + (wid >> 1); na_r0w = min(max(na_r - 4, 0), 120); }
    if constexpr (T == AT_NA) { for (int i = tid; i < 465; i += 512) ((LAS float*)(lds + BOFF))[i] = P.relb[h * 465 + i] * LOG2E; }

    const int krow0 = tid / KCH, kpc0 = tid % KCH, krow1 = (tid + 512) / KCH, kpc1 = (tid + 512) % KCH, vrow = tid >> 3, vpc = tid & 7;
    float kgv[8];
    if constexpr (T != AT_MLA) {
#pragma unroll
        for (int j = 0; j < 8; ++j) kgv[j] = P.kg[kpc0 * 8 + j];
    }
    u32x4 kreg0 = {0, 0, 0, 0}, kreg1 = {0, 0, 0, 0}, vreg = {0, 0, 0, 0};
#define AT_LOAD(t) do { \
        if constexpr (T == AT_MLA) { \
            const bf16_t* kp = P.K + ((size_t)(b * 8 + h) * SEQ + (size_t)(t) * 64) * 96; \
            kreg0 = *(const u32x4*)(kp + tid * 8); if (tid < 256) kreg1 = *(const u32x4*)(kp + (tid + 512) * 8); \
            vreg = *(const u32x4*)(P.V + ((size_t)b * SEQ + (size_t)(t) * 64 + vrow) * 1024 + h * 128 + 64 + vpc * 8); \
        } else if constexpr (T == AT_MEM) { \
            kreg0 = *(const u32x4*)(P.K + ((size_t)b * NMEM + (t) * 64 + krow0) * 512 + h * 64 + kpc0 * 8); \
            vreg = *(const u32x4*)(P.V + ((size_t)b * NMEM + (t) * 64 + vrow) * 512 + 256 + h * 64 + vpc * 8); \
        } else { \
            const int kp_ = kbase0 + 64 * (t) + krow0; const bool ok_ = (kp_ >= 0) && (kp_ < SEQ); \
            const int hk_ = (T == AT_SWA) ? (h >> 1) : h; \
            const size_t ro_ = ((size_t)b * SEQ + (size_t)(ok_ ? kp_ : 0)) * ZW + hk_ * 64 + kpc0 * 8; \
            kreg0 = *(const u32x4*)(P.K + ro_); vreg = *(const u32x4*)(P.V + ro_); \
            if (!ok_) { kreg0 = (u32x4){0, 0, 0, 0}; vreg = (u32x4){0, 0, 0, 0}; } \
        } } while (0)
#define AT_STORE(bufi) do { \
        if constexpr (T != AT_MLA) { float f_[8]; unpack8(kreg0, f_); float ss_ = 0.f; \
            _Pragma("unroll") for (int j = 0; j < 8; ++j) ss_ += f_[j] * f_[j]; \
            ss_ += __shfl_xor(ss_, 1); ss_ += __shfl_xor(ss_, 2); ss_ += __shfl_xor(ss_, 4); \
            const float rs_ = rsqrtf(ss_ * (1.0f / 64.0f) + EPS); \
            _Pragma("unroll") for (int j = 0; j < 8; ++j) f_[j] *= rs_ * kgv[j]; \
            kreg0 = pack8(f_); } \
        *(LAS u32x4*)(lds + KOFF + (bufi) * KBUF + krow0 * KS + kpc0 * 16) = kreg0; \
        if constexpr (T == AT_MLA) { if (tid < 256) *(LAS u32x4*)(lds + KOFF + (bufi) * KBUF + krow1 * KS + kpc1 * 16) = kreg1; } \
        *(LAS u32x4*)(lds + VOFF + (bufi) * VBUF + vrow * VS + vpc * 16) = vreg; } while (0)

    AT_LOAD(0);
    bf16x8 qf[NS];
    {
        const bf16_t* qsrc = P.Q + qrow * P.ldq + P.qoff + h * DQK + 8 * hi;
        float qv[NS][8]; float ss = 0.f;
#pragma unroll
        for (int s = 0; s < NS; ++s) { const u32x4 w = *(const u32x4*)(qsrc + 16 * s); unpack8(w, qv[s]);
#pragma unroll
            for (int j = 0; j < 8; ++j) ss += qv[s][j] * qv[s][j]; }
        ss += __shfl_xor(ss, 32);
        const float rs = rsqrtf(ss * (1.0f / DQK) + EPS);
#pragma unroll
        for (int s = 0; s < NS; ++s) { const f32x4 g0 = *(const f32x4*)(P.qg + 16 * s + 8 * hi), g1 = *(const f32x4*)(P.qg + 16 * s + 8 * hi + 4);
#pragma unroll
            for (int j = 0; j < 4; ++j) { qv[s][j] *= rs * g0[j]; qv[s][4 + j] *= rs * g1[j]; } }
        if constexpr (T == AT_MLA) {
#pragma unroll
            for (int j = 0; j < 8; ++j) { float c, sn; rope_cs(qpos, 8 * hi + j, c, sn); const float x1 = qv[4][j], x2 = qv[5][j]; qv[4][j] = x1 * c - x2 * sn; qv[5][j] = x1 * sn + x2 * c; }
        }
        const float sc = ((T == AT_MLA) ? 0.10206207261596575f : 0.125f) * LOG2E;
#pragma unroll
        for (int s = 0; s < NS; ++s) {
#pragma unroll
            for (int j = 0; j < 8; ++j) qv[s][j] *= sc;
            qf[s] = __builtin_bit_cast(bf16x8, pack8(qv[s])); }
    }
    AT_STORE(0);
    LDS_BAR();

    f32x16 o0, o1;
#pragma unroll
    for (int r = 0; r < 16; ++r) { o0[r] = 0.f; o1[r] = 0.f; }
    float m_run = -1e30f, l_run = 0.f;
    const int q4 = (lane & 15) >> 2, p4 = lane & 3, blk = (lane >> 4) & 1;
    const int vfo = (4 * hi + q4) * VS + (16 * blk + 4 * p4) * 2;
    float slope2 = 0.f;
    if constexpr (T == AT_SWA) slope2 = exp2f(-2.0f * (float)(h + 1)) * LOG2E;
    const int qw0 = q0 + 32 * wid;
    const int na_c = qpos & 63, na_c0 = min(max(na_c - 8, 0), 48);

    for (int t = 0; t < nt; ++t) {
        const bool more = (t + 1 < nt);
        if (more) AT_LOAD(t + 1);
        const int kb0 = kbase0 + 64 * t;
        bool active = true;
        if constexpr (T == AT_SWA) active = (kb0 + 63 >= qw0 - 128) && (kb0 <= qw0 + 159) && (kb0 + 63 >= 0) && (kb0 < SEQ);
        if constexpr (T == AT_NA) { const int kr = na_kr0 + t; active = (kr >= na_r0w) && (kr <= na_r0w + 7); }
        if (active) {
            f32x16 p0, p1;
#pragma unroll
            for (int r = 0; r < 16; ++r) { p0[r] = 0.f; p1[r] = 0.f; }
            const LAS unsigned char* kb = lds + KOFF + (t & 1) * KBUF + r32 * KS + hi * 16;
#pragma unroll
            for (int s = 0; s < NS; ++s) {
                const bf16x8 k0 = *(const LAS bf16x8*)(kb + s * 32), k1 = *(const LAS bf16x8*)(kb + 32 * KS + s * 32);
                p0 = __builtin_amdgcn_mfma_f32_32x32x16_bf16(k0, qf[s], p0, 0, 0, 0);
                p1 = __builtin_amdgcn_mfma_f32_32x32x16_bf16(k1, qf[s], p1, 0, 0, 0);
            }
            if constexpr (T == AT_SWA) {
#pragma unroll
                for (int r = 0; r < 16; ++r) {
                    const int kp0 = kb0 + crow(r, hi), kp1 = kp0 + 32;
                    const int d0 = abs(qpos - kp0), d1 = abs(qpos - kp1);
                    p0[r] = (d0 <= 128 && kp0 >= 0 && kp0 < SEQ) ? p0[r] - slope2 * (float)d0 : -1e30f;
                    p1[r] = (d1 <= 128 && kp1 >= 0 && kp1 < SEQ) ? p1[r] - slope2 * (float)d1 : -1e30f;
                }
            }
            if constexpr (T == AT_NA) {
                const int dr = (na_kr0 + t) - na_r + 7;
                const LAS float* bt = (const LAS float*)(lds + BOFF) + dr * 31 + 15 - na_c;
                const LAS unsigned char* vb = lds + VOFF + (t & 1) * VBUF + vfo;
#define NA_EL(PX, r, KO) do { const int kc_ = crow(r, hi) + (KO); const bool ok_ = (unsigned)(kc_ - na_c0) < 16u; const float b_ = bt[ok_ ? kc_ : na_c]; PX[r] = ok_ ? PX[r] + b_ : -1e30f; } while (0)
#define NA_PV(s_, PA) do { const s16x4 a0 = vtr(vb + (16 * (s_)) * VS), a1 = vtr(vb + (16 * (s_) + 8) * VS), c0 = vtr(vb + (16 * (s_)) * VS + 64), c1 = vtr(vb + (16 * (s_) + 8) * VS + 64); \
                    const bf16x8 v0 = __builtin_shufflevector(a0, a1, 0, 1, 2, 3, 4, 5, 6, 7), v1 = __builtin_shufflevector(c0, c1, 0, 1, 2, 3, 4, 5, 6, 7); \
                    o0 = __builtin_amdgcn_mfma_f32_32x32x16_bf16(v0, PA, o0, 0, 0, 0); o1 = __builtin_amdgcn_mfma_f32_32x32x16_bf16(v1, PA, o1, 0, 0, 0); } while (0)
                const bool lo_half = ((wid & 1) == 0);
                float mx = -1e30f;
                if (lo_half) {
#pragma unroll
                    for (int r = 0; r < 16; ++r) { NA_EL(p0, r, 0); mx = fmaxf(mx, p0[r]); }
#pragma unroll
                    for (int r = 0; r < 4; ++r) { NA_EL(p1, r, 32); mx = fmaxf(mx, p1[r]); }
                } else {
#pragma unroll
                    for (int r = 12; r < 16; ++r) { NA_EL(p0, r, 0); mx = fmaxf(mx, p0[r]); }
#pragma unroll
                    for (int r = 0; r < 16; ++r) { NA_EL(p1, r, 32); mx = fmaxf(mx, p1[r]); }
                }
                mx = fmaxf(mx, __shfl_xor(mx, 32));
                const float mn = fmaxf(fmaxf(m_run, mx), -1e20f);
                const float alpha = __builtin_amdgcn_exp2f(m_run - mn);
                m_run = mn; l_run *= alpha;
                if (__any(alpha != 1.0f)) {
#pragma unroll
                    for (int r = 0; r < 16; ++r) { o0[r] *= alpha; o1[r] *= alpha; }
                }
                float ps = 0.f; u32x4 w;
                if (lo_half) {
#pragma unroll
                    for (int r = 0; r < 16; ++r) { p0[r] = __builtin_amdgcn_exp2f(p0[r] - mn); ps += p0[r]; }
#pragma unroll
                    for (int r = 0; r < 4; ++r) { p1[r] = __builtin_amdgcn_exp2f(p1[r] - mn); ps += p1[r]; }
                    w.x = pk2(p0[0], p0[1]); w.y = pk2(p0[2], p0[3]); w.z = pk2(p0[4], p0[5]); w.w = pk2(p0[6], p0[7]); const bf16x8 q0_ = __builtin_bit_cast(bf16x8, w);
                    w.x = pk2(p0[8], p0[9]); w.y = pk2(p0[10], p0[11]); w.z = pk2(p0[12], p0[13]); w.w = pk2(p0[14], p0[15]); const bf16x8 q1_ = __builtin_bit_cast(bf16x8, w);
                    w.x = pk2(p1[0], p1[1]); w.y = pk2(p1[2], p1[3]); w.z = 0u; w.w = 0u; const bf16x8 q2_ = __builtin_bit_cast(bf16x8, w);
                    NA_PV(0, q0_); NA_PV(1, q1_); NA_PV(2, q2_);
                } else {
#pragma unroll
                    for (int r = 12; r < 16; ++r) { p0[r] = __builtin_amdgcn_exp2f(p0[r] - mn); ps += p0[r]; }
#pragma unroll
                    for (int r = 0; r < 16; ++r) { p1[r] = __builtin_amdgcn_exp2f(p1[r] - mn); ps += p1[r]; }
                    w.x = 0u; w.y = 0u; w.z = pk2(p0[12], p0[13]); w.w = pk2(p0[14], p0[15]); const bf16x8 q1_ = __builtin_bit_cast(bf16x8, w);
                    w.x = pk2(p1[0], p1[1]); w.y = pk2(p1[2], p1[3]); w.z = pk2(p1[4], p1[5]); w.w = pk2(p1[6], p1[7]); const bf16x8 q2_ = __builtin_bit_cast(bf16x8, w);
                    w.x = pk2(p1[8], p1[9]); w.y = pk2(p1[10], p1[11]); w.z = pk2(p1[12], p1[13]); w.w = pk2(p1[14], p1[15]); const bf16x8 q3_ = __builtin_bit_cast(bf16x8, w);
                    NA_PV(1, q1_); NA_PV(2, q2_); NA_PV(3, q3_);
                }
                l_run += ps;
#undef NA_EL
#undef NA_PV
            } else {
            float mx = fmaxf(p0[0], p1[0]);
#pragma unroll
            for (int r = 1; r < 16; ++r) mx = fmaxf(mx, fmaxf(p0[r], p1[r]));
            mx = fmaxf(mx, __shfl_xor(mx, 32));
            const float mn = fmaxf(fmaxf(m_run, mx), -1e20f);
            const float alpha = __builtin_amdgcn_exp2f(m_run - mn);
            m_run = mn; l_run *= alpha;
            if (__any(alpha != 1.0f)) {
#pragma unroll
                for (int r = 0; r < 16; ++r) { o0[r] *= alpha; o1[r] *= alpha; }
            }
            float ps = 0.f;
#pragma unroll
            for (int r = 0; r < 16; ++r) { p0[r] = __builtin_amdgcn_exp2f(p0[r] - mn); p1[r] = __builtin_amdgcn_exp2f(p1[r] - mn); ps += p0[r] + p1[r]; }
            l_run += ps;
            bf16x8 pa[4];
            { u32x4 w;
              w.x = pk2(p0[0], p0[1]); w.y = pk2(p0[2], p0[3]); w.z = pk2(p0[4], p0[5]); w.w = pk2(p0[6], p0[7]); pa[0] = __builtin_bit_cast(bf16x8, w);
              w.x = pk2(p0[8], p0[9]); w.y = pk2(p0[10], p0[11]); w.z = pk2(p0[12], p0[13]); w.w = pk2(p0[14], p0[15]); pa[1] = __builtin_bit_cast(bf16x8, w);
              w.x = pk2(p1[0], p1[1]); w.y = pk2(p1[2], p1[3]); w.z = pk2(p1[4], p1[5]); w.w = pk2(p1[6], p1[7]); pa[2] = __builtin_bit_cast(bf16x8, w);
              w.x = pk2(p1[8], p1[9]); w.y = pk2(p1[10], p1[11]); w.z = pk2(p1[12], p1[13]); w.w = pk2(p1[14], p1[15]); pa[3] = __builtin_bit_cast(bf16x8, w); }
            const LAS unsigned char* vb = lds + VOFF + (t & 1) * VBUF + vfo;
#pragma unroll
            for (int s = 0; s < 4; ++s) {
                const s16x4 a0 = vtr(vb + (16 * s) * VS), a1 = vtr(vb + (16 * s + 8) * VS), c0 = vtr(vb + (16 * s) * VS + 64), c1 = vtr(vb + (16 * s + 8) * VS + 64);
                const bf16x8 v0 = __builtin_shufflevector(a0, a1, 0, 1, 2, 3, 4, 5, 6, 7), v1 = __builtin_shufflevector(c0, c1, 0, 1, 2, 3, 4, 5, 6, 7);
                o0 = __builtin_amdgcn_mfma_f32_32x32x16_bf16(v0, pa[s], o0, 0, 0, 0);
                o1 = __builtin_amdgcn_mfma_f32_32x32x16_bf16(v1, pa[s], o1, 0, 0, 0);
            }
            }
        }
        if (more) AT_STORE((t + 1) & 1);
        LDS_BAR();
    }
#undef AT_LOAD
#undef AT_STORE
    float l_tot = l_run + __shfl_xor(l_run, 32);
    if constexpr (T == AT_SWA) l_tot += __builtin_amdgcn_exp2f(P.sink[h] * LOG2E - m_run);
    const float inv = 1.0f / l_tot;
    bf16_t* dst = P.O + qrow * P.ldo + P.ooff + h * 64 + 4 * hi;
#pragma unroll
    for (int g = 0; g < 4; ++g) {
        u32x2 w0, w1;
        w0.x = pk2(o0[4 * g] * inv, o0[4 * g + 1] * inv); w0.y = pk2(o0[4 * g + 2] * inv, o0[4 * g + 3] * inv);
        w1.x = pk2(o1[4 * g] * inv, o1[4 * g + 1] * inv); w1.y = pk2(o1[4 * g + 2] * inv, o1[4 * g + 3] * inv);
        *(u32x2*)(dst + 8 * g) = w0; *(u32x2*)(dst + 32 + 8 * g) = w1;
    }
}


DI void mla_unit(const AttnP& P, const int b, const int h, const int qb, LAS unsigned char* lds) {
    constexpr int DQK = 96, NS = 6, KS = 208, VS = 192, KBUF = 64 * KS, VBUF = 64 * VS, NT = SEQ / 64;
    constexpr int KOFF = 0, VOFF = 3 * KBUF;
    int tid = threadIdx.x; asm volatile("" : "+v"(tid));
    const int lane = tid & 63, wid = __builtin_amdgcn_readfirstlane(tid >> 6), r32 = lane & 31, hi = lane >> 5, grp = wid >> 2;
    const int q0 = qb * 256, qpos = q0 + 32 * wid + r32;
    const size_t qrow = (size_t)b * SEQ + qpos;
    const int krow0 = tid / 12, kpc0 = tid % 12, krow1 = (tid + 512) / 12, kpc1 = (tid + 512) % 12, vrow = tid >> 3, vpc = tid & 7;
    const bf16_t* kbase = P.K + ((size_t)(b * 8 + h) * SEQ) * 96 + tid * 8;
    const bf16_t* vbase = P.V + ((size_t)b * SEQ + vrow) * 1024 + h * 128 + 64 + vpc * 8;
    u32x4 kreg0, kreg1 = {0, 0, 0, 0}, vreg;
#define ML_LOAD(t) do { const bf16_t* kp_ = kbase + (size_t)(t) * (64 * 96); kreg0 = *(const u32x4*)kp_; if (tid < 256) kreg1 = *(const u32x4*)(kp_ + 512 * 8); \
        vreg = *(const u32x4*)(vbase + (size_t)(t) * (64 * 1024)); } while (0)
#define ML_STORE(bufi) do { *(LAS u32x4*)(lds + KOFF + (bufi) * KBUF + krow0 * KS + kpc0 * 16) = kreg0; \
        if (tid < 256) *(LAS u32x4*)(lds + KOFF + (bufi) * KBUF + krow1 * KS + kpc1 * 16) = kreg1; \
        *(LAS u32x4*)(lds + VOFF + (bufi) * VBUF + vrow * VS + vpc * 16) = vreg; } while (0)
    ML_LOAD(0);
    bf16x8 qf[NS];
    {
        const bf16_t* qsrc = P.Q + qrow * P.ldq + P.qoff + h * DQK + 8 * hi;
        float qv[NS][8]; float ss = 0.f;
#pragma unroll
        for (int s = 0; s < NS; ++s) { const u32x4 w = *(const u32x4*)(qsrc + 16 * s); unpack8(w, qv[s]);
#pragma unroll
            for (int j = 0; j < 8; ++j) ss += qv[s][j] * qv[s][j]; }
        ss += __shfl_xor(ss, 32);
        const float rs = rsqrtf(ss * (1.0f / DQK) + EPS);
#pragma unroll
        for (int s = 0; s < NS; ++s) { const f32x4 g0 = *(const f32x4*)(P.qg + 16 * s + 8 * hi), g1 = *(const f32x4*)(P.qg + 16 * s + 8 * hi + 4);
#pragma unroll
            for (int j = 0; j < 4; ++j) { qv[s][j] *= rs * g0[j]; qv[s][4 + j] *= rs * g1[j]; } }
#pragma unroll
        for (int j = 0; j < 8; ++j) { float c, sn; rope_cs(qpos, 8 * hi + j, c, sn); const float x1 = qv[4][j], x2 = qv[5][j]; qv[4][j] = x1 * c - x2 * sn; qv[5][j] = x1 * sn + x2 * c; }
        const float sc = 0.10206207261596575f * LOG2E;
#pragma unroll
        for (int s = 0; s < NS; ++s) {
#pragma unroll
            for (int j = 0; j < 8; ++j) qv[s][j] *= sc;
            qf[s] = __builtin_bit_cast(bf16x8, pack8(qv[s])); }
    }
    ML_STORE(0);
    ML_LOAD(1);
    LDS_BAR();

    f32x16 o0, o1, o2, p0, p1, negm;
#pragma unroll
    for (int r = 0; r < 16; ++r) { o0[r] = 0.f; o1[r] = 0.f; o2[r] = 0.f; p0[r] = 0.f; p1[r] = 0.f; negm[r] = 0.f; }
    const bf16x8 ones = {0x3F80, 0x3F80, 0x3F80, 0x3F80, 0x3F80, 0x3F80, 0x3F80, 0x3F80};
    bf16x8 pa0 = {0, 0, 0, 0, 0, 0, 0, 0}, pa1 = pa0, pa2 = pa0, pa3 = pa0;
    float m_run = 0.f;
    const int q4 = (lane & 15) >> 2, p4 = lane & 3, blk = (lane >> 4) & 1;
    const int vfo = (4 * hi + q4) * VS + (16 * blk + 4 * p4) * 2;
    const int kfo = r32 * KS + hi * 16;
    bf16x8 fa_[2], fb_[2];

#define ML_SB __builtin_amdgcn_sched_barrier(0)
#define ML_NOPS asm volatile("s_nop 15\n\ts_nop 7" : "+v"(p0), "+v"(p1))
#define ML_VLD(dst, s_) do { const s16x4 a0_ = vtr(vb_ + (16 * (s_)) * VS), a1_ = vtr(vb_ + (16 * (s_) + 8) * VS), c0_ = vtr(vb_ + (16 * (s_)) * VS + 64), c1_ = vtr(vb_ + (16 * (s_) + 8) * VS + 64); \
        dst[0] = __builtin_shufflevector(a0_, a1_, 0, 1, 2, 3, 4, 5, 6, 7); dst[1] = __builtin_shufflevector(c0_, c1_, 0, 1, 2, 3, 4, 5, 6, 7); } while (0)
#define ML_KLD(dst, s_) do { dst[0] = *(const LAS bf16x8*)(kb_ + (s_) * 32); dst[1] = *(const LAS bf16x8*)(kb_ + 32 * KS + (s_) * 32); } while (0)
#define ML_PVM(v, pp) do { o0 = __builtin_amdgcn_mfma_f32_32x32x16_bf16(v[0], pp, o0, 0, 0, 0); o1 = __builtin_amdgcn_mfma_f32_32x32x16_bf16(v[1], pp, o1, 0, 0, 0); } while (0)
#define ML_LSUM(pp) do { o2 = __builtin_amdgcn_mfma_f32_32x32x16_bf16(ones, pp, o2, 0, 0, 0); } while (0)
#define ML_QKM(k, s_, c0, c1) do { p0 = __builtin_amdgcn_mfma_f32_32x32x16_bf16(k[0], qf[s_], c0, 0, 0, 0); p1 = __builtin_amdgcn_mfma_f32_32x32x16_bf16(k[1], qf[s_], c1, 0, 0, 0); } while (0)
#define ML_PTRS(bk, bv) __builtin_amdgcn_s_setprio(2); const LAS unsigned char* vb_ = lds + VOFF + (bv) * VBUF + vfo; const LAS unsigned char* kb_ = lds + KOFF + (bk) * KBUF + kfo; bf16x8 fc_[2], fd_[2]
#define ML_MFMA_FULL(bk, bv) do { ML_PTRS(bk, bv); \
            ML_VLD(fc_, 2); ML_VLD(fd_, 3); ML_PVM(fa_, pa0); ML_LSUM(pa0); ML_PVM(fb_, pa1); ML_LSUM(pa1); ML_SB; \
            ML_KLD(fa_, 0); ML_KLD(fb_, 1); ML_PVM(fc_, pa2); ML_LSUM(pa2); ML_PVM(fd_, pa3); ML_LSUM(pa3); ML_SB; \
            ML_KLD(fc_, 2); ML_KLD(fd_, 3); ML_QKM(fa_, 0, negm, negm); ML_QKM(fb_, 1, p0, p1); ML_SB; \
            ML_KLD(fa_, 4); ML_KLD(fb_, 5); ML_QKM(fc_, 2, p0, p1); ML_QKM(fd_, 3, p0, p1); ML_SB; \
            ML_QKM(fa_, 4, p0, p1); ML_QKM(fb_, 5, p0, p1); ML_NOPS; ML_SB; __builtin_amdgcn_s_setprio(0); } while (0)
#define ML_MFMA_FIRST(bk) do { ML_PTRS(bk, 0); (void)vb_; \
            ML_KLD(fa_, 0); ML_KLD(fb_, 1); ML_SB; \
            ML_KLD(fc_, 2); ML_KLD(fd_, 3); ML_QKM(fa_, 0, negm, negm); ML_QKM(fb_, 1, p0, p1); ML_SB; \
            ML_KLD(fa_, 4); ML_KLD(fb_, 5); ML_QKM(fc_, 2, p0, p1); ML_QKM(fd_, 3, p0, p1); ML_SB; \
            ML_QKM(fa_, 4, p0, p1); ML_QKM(fb_, 5, p0, p1); ML_NOPS; ML_SB; __builtin_amdgcn_s_setprio(0); } while (0)
#define ML_MFMA_LAST(bv) do { ML_PTRS(0, bv); (void)kb_; \
            ML_VLD(fc_, 2); ML_VLD(fd_, 3); ML_PVM(fa_, pa0); ML_LSUM(pa0); ML_PVM(fb_, pa1); ML_LSUM(pa1); ML_SB; \
            ML_PVM(fc_, pa2); ML_LSUM(pa2); ML_PVM(fd_, pa3); ML_LSUM(pa3); ML_SB; __builtin_amdgcn_s_setprio(0); } while (0)
#define ML_SOFTMAX(first_, bvn_) do { \
        float ma_ = max3f(p0[0], p0[1], p1[0]), mb_ = max3f(p0[2], p0[3], p1[1]); ma_ = max3f(ma_, p1[2], p1[3]); \
        _Pragma("unroll") for (int r = 4; r < 16; r += 4) { ma_ = max3f(ma_, p0[r], p0[r + 1]); mb_ = max3f(mb_, p0[r + 2], p0[r + 3]); ma_ = max3f(ma_, p1[r], p1[r + 1]); mb_ = max3f(mb_, p1[r + 2], p1[r + 3]); } \
        float mx_ = max3f(ma_, mb_, mb_); \
        mx_ = max3f(mx_, __shfl_xor(mx_, 32), mx_); \
        if (first_ || __any(mx_ > 8.0f)) { const float dl_ = first_ ? mx_ : max3f(mx_, 0.0f, 0.0f); m_run += dl_; \
            _Pragma("unroll") for (int r = 0; r < 16; ++r) { p0[r] -= dl_; p1[r] -= dl_; negm[r] = -m_run; } \
            if (!first_) { const float f_ = __builtin_amdgcn_exp2f(-dl_); \
                _Pragma("unroll") for (int r = 0; r < 16; ++r) { o0[r] *= f_; o1[r] *= f_; o2[r] *= f_; } } } \
        _Pragma("unroll") for (int r = 0; r < 16; ++r) { p0[r] = __builtin_amdgcn_exp2f(p0[r]); p1[r] = __builtin_amdgcn_exp2f(p1[r]); } \
        { u32x4 w_; \
          w_.x = pk2(p0[0], p0[1]); w_.y = pk2(p0[2], p0[3]); w_.z = pk2(p0[4], p0[5]); w_.w = pk2(p0[6], p0[7]); pa0 = __builtin_bit_cast(bf16x8, w_); \
          w_.x = pk2(p0[8], p0[9]); w_.y = pk2(p0[10], p0[11]); w_.z = pk2(p0[12], p0[13]); w_.w = pk2(p0[14], p0[15]); pa1 = __builtin_bit_cast(bf16x8, w_); \
          w_.x = pk2(p1[0], p1[1]); w_.y = pk2(p1[2], p1[3]); w_.z = pk2(p1[4], p1[5]); w_.w = pk2(p1[6], p1[7]); pa2 = __builtin_bit_cast(bf16x8, w_); \
          w_.x = pk2(p1[8], p1[9]); w_.y = pk2(p1[10], p1[11]); w_.z = pk2(p1[12], p1[13]); w_.w = pk2(p1[14], p1[15]); pa3 = __builtin_bit_cast(bf16x8, w_); } \
        { const LAS unsigned char* vb_ = lds + VOFF + (bvn_) * VBUF + vfo; ML_VLD(fa_, 0); ML_VLD(fb_, 1); } } while (0)

#define ML_LDST(i) do { ML_STORE(bl); { const int tn_ = ((i) + 2 < NT) ? (i) + 2 : NT - 1; ML_LOAD(tn_); } } while (0)
#define ML_ROT() do { bv = bk; bk = bl; bl = (bl == 2) ? 0 : bl + 1; } while (0)
    int bk = 0, bv = 2, bl = 1;
    if (grp == 0) {
        ML_MFMA_FIRST(bk); ML_LDST(0); LDS_BAR();
        ML_SOFTMAX(true, bk); LDS_BAR(); ML_ROT();
        for (int i = 1; i < NT; ++i) {
            ML_MFMA_FULL(bk, bv); ML_LDST(i); LDS_BAR();
            ML_SOFTMAX(false, bk); LDS_BAR(); ML_ROT();
        }
        ML_MFMA_LAST(bv); LDS_BAR();
        LDS_BAR();
    } else {
        ML_LDST(0); LDS_BAR();
        ML_MFMA_FIRST(bk); LDS_BAR(); ML_ROT();
        ML_SOFTMAX(true, bv); ML_LDST(1); LDS_BAR();
        ML_MFMA_FULL(bk, bv); LDS_BAR(); ML_ROT();
        for (int i = 2; i < NT; ++i) {
            ML_SOFTMAX(false, bv); ML_LDST(i); LDS_BAR();
            ML_MFMA_FULL(bk, bv); LDS_BAR(); ML_ROT();
        }
        ML_SOFTMAX(false, bv); LDS_BAR();
        ML_MFMA_LAST(bv); LDS_BAR();
    }
#undef ML_LDST
#undef ML_ROT
#undef ML_PTRS
#undef ML_MFMA_FULL
#undef ML_MFMA_FIRST
#undef ML_MFMA_LAST
#undef ML_LOAD
#undef ML_STORE
#undef ML_SB
#undef ML_NOPS
#undef ML_LSUM
#undef ML_VLD
#undef ML_KLD
#undef ML_PVM
#undef ML_QKM
#undef ML_SOFTMAX
    const float inv = 1.0f / o2[0];
    bf16_t* dst = P.O + qrow * P.ldo + P.ooff + h * 64 + 4 * hi;
#pragma unroll
    for (int g = 0; g < 4; ++g) {
        u32x2 w0, w1;
        w0.x = pk2(o0[4 * g] * inv, o0[4 * g + 1] * inv); w0.y = pk2(o0[4 * g + 2] * inv, o0[4 * g + 3] * inv);
        w1.x = pk2(o1[4 * g] * inv, o1[4 * g + 1] * inv); w1.y = pk2(o1[4 * g + 2] * inv, o1[4 * g + 3] * inv);
        *(u32x2*)(dst + 8 * g) = w0; *(u32x2*)(dst + 32 + 8 * g) = w1;
    }
}


DI void glds16(const void* gsrc, unsigned lds_dst) { unsigned keep;
    asm volatile("s_mov_b32 %0, m0\n\ts_mov_b32 m0, %2\n\ts_nop 0\n\tglobal_load_lds_dwordx4 %1, off\n\ts_mov_b32 m0, %0" : "=&s"(keep) : "v"(gsrc), "s"(lds_dst) : "memory"); }
DI void mla_unit_fast(const AttnP& P, const int b, const int h, const int qb, LAS unsigned char* lds) {
    constexpr int DQK = 96, NS = 6, KS = 208, VS = 192, KBUF = 64 * KS, VBUF = 64 * VS, SLOT = KBUF + VBUF, NT = SEQ / 64;
    int tid = threadIdx.x; asm volatile("" : "+v"(tid));
    const int lane = tid & 63, wid = __builtin_amdgcn_readfirstlane(tid >> 6), r32 = lane & 31, hi = lane >> 5, grp = wid >> 2;
    const int q0 = qb * 256, qpos = q0 + 32 * wid + r32;
    const size_t qrow = (size_t)b * SEQ + qpos;
    const char* kbase = (const char*)(P.K + ((size_t)(b * 8 + h) * SEQ) * 96);
    const char* vbase = (const char*)(P.V + ((size_t)b * SEQ) * 1024 + h * 128 + 64);
    unsigned goff0, goff1, goff2, goff3 = 0; unsigned l0, l1, l2, l3 = 0; bool v1;
    { int sg = 64 * wid + lane; int r = sg / 13, c = sg % 13; goff0 = (unsigned)(r * 192 + (c < 12 ? c : 11) * 16); l0 = (unsigned)(wid * 1024); }
    if (wid <= 4) { int sg = 64 * (wid + 8) + lane; int r = sg / 13, c = sg % 13; goff1 = (unsigned)(r * 192 + (c < 12 ? c : 11) * 16); l1 = (unsigned)((wid + 8) * 1024); v1 = false; }
    else          { int sg = 64 * (wid - 5) + lane; int r = sg / 12, c = sg % 12; goff1 = (unsigned)(r * 2048 + (c < 8 ? c : 7) * 16); l1 = (unsigned)(KBUF + (wid - 5) * 1024); v1 = true; }
    { int sg = 64 * (wid + 3) + lane; int r = sg / 12, c = sg % 12; goff2 = (unsigned)(r * 2048 + (c < 8 ? c : 7) * 16); l2 = (unsigned)(KBUF + (wid + 3) * 1024); }
    if (wid == 0) { int sg = 64 * 11 + lane; int r = sg / 12, c = sg % 12; goff3 = (unsigned)(r * 2048 + (c < 8 ? c : 7) * 16); l3 = (unsigned)(KBUF + 11 * 1024); }
    const unsigned ldsb = (unsigned)(size_t)lds;
#define MF_DMA(t, rs) do { const char* kt_ = kbase + (size_t)(t) * 12288; const char* vt_ = vbase + (size_t)(t) * 131072; const unsigned sb_ = ldsb + (unsigned)(rs) * SLOT; \
        glds16(kt_ + goff0, (unsigned)__builtin_amdgcn_readfirstlane((int)(sb_ + l0))); \
        glds16((v1 ? vt_ : kt_) + goff1, (unsigned)__builtin_amdgcn_readfirstlane((int)(sb_ + l1))); \
        glds16(vt_ + goff2, (unsigned)__builtin_amdgcn_readfirstlane((int)(sb_ + l2))); \
        if (wid == 0) glds16(vt_ + goff3, (unsigned)__builtin_amdgcn_readfirstlane((int)(sb_ + l3))); } while (0)
    MF_DMA(0, 0); MF_DMA(1, 1); MF_DMA(2, 2);
    bf16x8 qf[NS];
    {
        const bf16_t* qsrc = P.Q + qrow * P.ldq + P.qoff + h * DQK + 8 * hi;
        float qv[NS][8]; float ss = 0.f;
#pragma unroll
        for (int s = 0; s < NS; ++s) { const u32x4 w = *(const u32x4*)(qsrc + 16 * s); unpack8(w, qv[s]);
#pragma unroll
            for (int j = 0; j < 8; ++j) ss += qv[s][j] * qv[s][j]; }
        ss += __shfl_xor(ss, 32);
        const float rs = rsqrtf(ss * (1.0f / DQK) + EPS);
#pragma unroll
        for (int s = 0; s < NS; ++s) { const f32x4 g0 = *(const f32x4*)(P.qg + 16 * s + 8 * hi), g1 = *(const f32x4*)(P.qg + 16 * s + 8 * hi + 4);
#pragma unroll
            for (int j = 0; j < 4; ++j) { qv[s][j] *= rs * g0[j]; qv[s][4 + j] *= rs * g1[j]; } }
#pragma unroll
        for (int j = 0; j < 8; ++j) { float c, sn; rope_cs(qpos, 8 * hi + j, c, sn); const float x1 = qv[4][j], x2 = qv[5][j]; qv[4][j] = x1 * c - x2 * sn; qv[5][j] = x1 * sn + x2 * c; }
        const float sc = 0.10206207261596575f * LOG2E;
#pragma unroll
        for (int s = 0; s < NS; ++s) {
#pragma unroll
            for (int j = 0; j < 8; ++j) qv[s][j] *= sc;
            qf[s] = __builtin_bit_cast(bf16x8, pack8(qv[s])); }
    }
    asm volatile("s_waitcnt vmcnt(0)" ::: "memory");
    LDS_BAR();

    f32x16 o0, o1, pA0, pA1, pB0, pB1, z16;
#pragma unroll
    for (int r = 0; r < 16; ++r) { o0[r] = 0.f; o1[r] = 0.f; pA0[r] = 0.f; pA1[r] = 0.f; pB0[r] = 0.f; pB1[r] = 0.f; z16[r] = 0.f; }
    bf16x8 pa0, pa1, pa2, pa3;
    float l_run = 0.f;
    const int q4 = (lane & 15) >> 2, p4 = lane & 3, blk = (lane >> 4) & 1;
    const int vfo = KBUF + (4 * hi + q4) * VS + (16 * blk + 4 * p4) * 2;
    const int kfo = r32 * KS + hi * 16;
#define MF_SB __builtin_amdgcn_sched_barrier(0)
#define MF_VLD(dst, s_) do { const s16x4 a0_ = vtr(vb_ + (16 * (s_)) * VS), a1_ = vtr(vb_ + (16 * (s_) + 8) * VS), c0_ = vtr(vb_ + (16 * (s_)) * VS + 64), c1_ = vtr(vb_ + (16 * (s_) + 8) * VS + 64); \
        dst[0] = __builtin_shufflevector(a0_, a1_, 0, 1, 2, 3, 4, 5, 6, 7); dst[1] = __builtin_shufflevector(c0_, c1_, 0, 1, 2, 3, 4, 5, 6, 7); } while (0)
#define MF_KLD(dst, s_) do { dst[0] = *(const LAS bf16x8*)(kb_ + (s_) * 32); dst[1] = *(const LAS bf16x8*)(kb_ + 32 * KS + (s_) * 32); } while (0)
#define MF_PVM(v, pp) do { o0 = __builtin_amdgcn_mfma_f32_32x32x16_bf16(v[0], pp, o0, 0, 0, 0); o1 = __builtin_amdgcn_mfma_f32_32x32x16_bf16(v[1], pp, o1, 0, 0, 0); } while (0)
#define MF_QKM(PO0, PO1, k, s_, c0, c1) do { PO0 = __builtin_amdgcn_mfma_f32_32x32x16_bf16(k[0], qf[s_], c0, 0, 0, 0); PO1 = __builtin_amdgcn_mfma_f32_32x32x16_bf16(k[1], qf[s_], c1, 0, 0, 0); } while (0)
#define MF_SMX(PX, B8, PAK) do { float e_[8]; float ps_ = 0.f; \
        _Pragma("unroll") for (int j = 0; j < 8; ++j) { e_[j] = __builtin_amdgcn_exp2f(PX[(B8) + j]); ps_ += e_[j]; } \
        l_run += ps_; PAK = __builtin_bit_cast(bf16x8, pack8(e_)); } while (0)
#define MF_LAND(t) do { if ((t) + 3 < NT) asm volatile("s_waitcnt vmcnt(3)" ::: "memory"); else asm volatile("s_waitcnt vmcnt(0)" ::: "memory"); } while (0)
#define MF_ITER(t, PI0, PI1, PO0, PO1) do { \
        const LAS unsigned char* kb_ = lds + (((t) + 1) & 3) * SLOT + kfo; const LAS unsigned char* vb_ = lds + ((t) & 3) * SLOT + vfo; \
        bf16x8 fa_[2], fb_[2], fc_[2], fd_[2]; \
        MF_KLD(fa_, 0); MF_KLD(fb_, 1); MF_SB; \
        if ((t) + 3 < NT) MF_DMA((t) + 3, ((t) + 3) & 3);         \
        __builtin_amdgcn_s_setprio(1); \
        MF_KLD(fc_, 2); MF_KLD(fd_, 3); MF_QKM(PO0, PO1, fa_, 0, z16, z16); MF_QKM(PO0, PO1, fb_, 1, PO0, PO1); MF_SMX(PI0, 0, pa0); MF_SB; \
        MF_KLD(fa_, 4); MF_KLD(fb_, 5); MF_QKM(PO0, PO1, fc_, 2, PO0, PO1); MF_QKM(PO0, PO1, fd_, 3, PO0, PO1); MF_SMX(PI0, 8, pa1); MF_SB; \
        MF_VLD(fc_, 0); MF_VLD(fd_, 1); MF_QKM(PO0, PO1, fa_, 4, PO0, PO1); MF_QKM(PO0, PO1, fb_, 5, PO0, PO1); MF_SMX(PI1, 0, pa2); MF_SB; \
        MF_VLD(fa_, 2); MF_VLD(fb_, 3); MF_SMX(PI1, 8, pa3); MF_PVM(fc_, pa0); MF_PVM(fd_, pa1); MF_SB; \
        MF_PVM(fa_, pa2); MF_PVM(fb_, pa3); MF_SB; \
        __builtin_amdgcn_s_setprio(0); \
        MF_LAND(t); LDS_BAR(); } while (0)
    {
        const LAS unsigned char* kb_ = lds + kfo; bf16x8 fa_[2], fb_[2], fc_[2], fd_[2];
        MF_KLD(fa_, 0); MF_KLD(fb_, 1); MF_KLD(fc_, 2); MF_KLD(fd_, 3);
        MF_QKM(pA0, pA1, fa_, 0, z16, z16); MF_QKM(pA0, pA1, fb_, 1, pA0, pA1); MF_KLD(fa_, 4); MF_KLD(fb_, 5);
        MF_QKM(pA0, pA1, fc_, 2, pA0, pA1); MF_QKM(pA0, pA1, fd_, 3, pA0, pA1); MF_QKM(pA0, pA1, fa_, 4, pA0, pA1); MF_QKM(pA0, pA1, fb_, 5, pA0, pA1);
    }
    for (int t = 0; t < NT - 2; t += 2) {
        MF_ITER(t, pA0, pA1, pB0, pB1);
        MF_ITER(t + 1, pB0, pB1, pA0, pA1);
    }
    MF_ITER(NT - 2, pA0, pA1, pB0, pB1);
    {
        const LAS unsigned char* vb_ = lds + ((NT - 1) & 3) * SLOT + vfo; bf16x8 fa_[2], fb_[2], fc_[2], fd_[2];
        MF_VLD(fc_, 0); MF_VLD(fd_, 1); MF_VLD(fa_, 2); MF_VLD(fb_, 3);
        MF_SMX(pB0, 0, pa0); MF_SMX(pB0, 8, pa1); MF_SMX(pB1, 0, pa2); MF_SMX(pB1, 8, pa3);
        MF_PVM(fc_, pa0); MF_PVM(fd_, pa1); MF_PVM(fa_, pa2); MF_PVM(fb_, pa3);
        LDS_BAR();
    }
#undef MF_DMA
#undef MF_SB
#undef MF_VLD
#undef MF_KLD
#undef MF_PVM
#undef MF_QKM
#undef MF_SMX
#undef MF_LAND
#undef MF_ITER
    const float inv = 1.0f / (l_run + __shfl_xor(l_run, 32));
    bf16_t* dst = P.O + qrow * P.ldo + P.ooff + h * 64 + 4 * hi;
#pragma unroll
    for (int g = 0; g < 4; ++g) {
        u32x2 w0, w1;
        w0.x = pk2(o0[4 * g] * inv, o0[4 * g + 1] * inv); w0.y = pk2(o0[4 * g + 2] * inv, o0[4 * g + 3] * inv);
        w1.x = pk2(o1[4 * g] * inv, o1[4 * g + 1] * inv); w1.y = pk2(o1[4 * g + 2] * inv, o1[4 * g + 3] * inv);
        *(u32x2*)(dst + 8 * g) = w0; *(u32x2*)(dst + 32 + 8 * g) = w1;
    }
}

DI void wprep_item(const float* W, int K, int N, const float* gain, bf16_t* WT, int mapmode, LAS float* scr, int item, int lane) {
    const int nblk = N / 32, kb = item / nblk, nb = item % nblk, k0 = 64 * kb, n0 = 32 * nb;
    int row0 = n0;
    if (mapmode == 1) { const int j = (n0 < DFF) ? n0 : n0 - DFF; row0 = 256 * (j / 128) + (j % 128) + ((n0 < DFF) ? 0 : 128); }
    if (mapmode == 2) row0 = (n0 < 416) ? n0 : n0 + 96;
    const int r8 = lane >> 3, c4 = (lane & 7) * 4;
    f32x4 wv[8];
#pragma unroll
    for (int i = 0; i < 8; ++i) wv[i] = *(const f32x4*)(W + (size_t)(k0 + 8 * i + r8) * N + n0 + c4);
#pragma unroll
    for (int i = 0; i < 8; ++i) { const int kk = 8 * i + r8; const float gk = gain ? gain[k0 + kk] : 1.0f;
        scr[kk * 33 + c4] = wv[i].x * gk; scr[kk * 33 + c4 + 1] = wv[i].y * gk; scr[kk * 33 + c4 + 2] = wv[i].z * gk; scr[kk * 33 + c4 + 3] = wv[i].w * gk; }
    asm volatile("s_waitcnt lgkmcnt(0)" ::: "memory");
    const int c = lane & 7;
#pragma unroll
    for (int j = 0; j < 4; ++j) { const int n = (lane >> 3) + 8 * j; const LAS float* s = scr + (8 * c) * 33 + n;
        u32x4 o; o.x = pk2(s[0 * 33], s[1 * 33]); o.y = pk2(s[2 * 33], s[3 * 33]); o.z = pk2(s[4 * 33], s[5 * 33]); o.w = pk2(s[6 * 33], s[7 * 33]);
        *(u32x4*)(WT + (size_t)(row0 + n) * K + k0 + 8 * c) = o; }
    asm volatile("s_waitcnt lgkmcnt(0)" ::: "memory");
}


#define XB_TMO      128
#define XB_XCNT(j)  (256  + 64 * (j))
#define XB_XSUB(j)  (1280 + 64 * (j))
#define XB_XGEN(j)  (2304 + 64 * (j))
#define XB_TOP      3328
#define XB_TOPGEN   3392
#define XCD_BAR_WORDS 3456
#define XB_SPIN_CAP (1u << 22)
DI unsigned xb_ld(unsigned* p)              { return __hip_atomic_load(p, __ATOMIC_RELAXED, __HIP_MEMORY_SCOPE_AGENT); }
DI unsigned xb_add(unsigned* p, unsigned v) { return __hip_atomic_fetch_add(p, v, __ATOMIC_RELAXED, __HIP_MEMORY_SCOPE_AGENT); }
DI unsigned xb_xcc_id() { return (unsigned)__builtin_amdgcn_s_getreg((3 << 11) | 20) & 0xFu; }
#define XB_SPIN(cond, bar) do { unsigned _sp = 0; while (cond) { __builtin_amdgcn_s_sleep(1); \
    if ((++_sp & 255u) == 0u) { if (xb_ld(&(bar)[XB_TMO])) break; if (_sp > XB_SPIN_CAP) { atomicAdd(&(bar)[XB_TMO], 1u); break; } } } } while (0)
struct XcdBarrier { unsigned* bar; unsigned x; volatile LAS unsigned* st; };
DI XcdBarrier xcd_barrier_post(unsigned* bar, volatile LAS unsigned* st) {
    XcdBarrier b; b.bar = bar; b.x = xb_xcc_id(); b.st = st;
    if (threadIdx.x == 0) (void)xb_add(&bar[XB_XCNT(b.x)], 1u);
    return b;
}
DI void xcd_barrier_complete(unsigned* bar, unsigned x, unsigned& nloc, unsigned& nx) {
    const unsigned G = gridDim.x * gridDim.y * gridDim.z;
    unsigned sum, cnt, mine, sp = 0u;
    for (;;) {
        sum = 0u; cnt = 0u; mine = 0u;
#pragma unroll
        for (unsigned j = 0; j < 16; ++j) { const unsigned c = xb_ld(&bar[XB_XCNT(j)]); sum += c; cnt += (c > 0u) ? 1u : 0u; mine = (j == x) ? c : mine; }
        if (sum == G) break;
        __builtin_amdgcn_s_sleep(1);
        if ((++sp & 255u) == 0u) { if (xb_ld(&bar[XB_TMO])) break; if (sp > XB_SPIN_CAP) { atomicAdd(&bar[XB_TMO], 1u); break; } }
    }
    nloc = mine > 0u ? mine : 1u; nx = cnt > 0u ? cnt : 1u;
}
DI void xcd_barrier(const XcdBarrier& b) {
    asm volatile("s_waitcnt vmcnt(0) lgkmcnt(0)" ::: "memory");
    __syncthreads();
    if (threadIdx.x == 0) {
        unsigned* bar = b.bar;
        __builtin_amdgcn_s_waitcnt(0);
        unsigned nloc = b.st[0], nx = b.st[1];
        if (nloc == 0u) { xcd_barrier_complete(bar, b.x, nloc, nx); b.st[0] = nloc; b.st[1] = nx; }
        const unsigned old = xb_add(&bar[XB_XSUB(b.x)], 1u);
        const unsigned gen = old / nloc;
        if (old + 1u == (gen + 1u) * nloc) {
            __builtin_amdgcn_fence(__ATOMIC_RELEASE, "agent");
            asm volatile("s_waitcnt vmcnt(0)" ::: "memory");
            const unsigned og = xb_add(&bar[XB_TOP], 1u);
            const unsigned tg = og / nx;
            if (og + 1u == (tg + 1u) * nx) xb_add(&bar[XB_TOPGEN], 1u);
            else XB_SPIN(xb_ld(&bar[XB_TOPGEN]) == tg, bar);
            __builtin_amdgcn_fence(__ATOMIC_ACQUIRE, "agent");
            xb_add(&bar[XB_XGEN(b.x)], 1u);
            asm volatile("s_waitcnt vmcnt(0)" ::: "memory");
        } else {
            XB_SPIN(xb_ld(&bar[XB_XGEN(b.x)]) == gen, bar);
            __builtin_amdgcn_fence(__ATOMIC_ACQUIRE, "agent");
            asm volatile("s_waitcnt vmcnt(0)" ::: "memory");
        }
    }
    __syncthreads();
}

struct Args { const float* in[32]; float* out; unsigned char* ws; int ph_lo, ph_hi; };
typedef __attribute__((address_space(4))) const Args ArgsK;
struct ArgsV { const ArgsK* p; struct InV { const ArgsK* p; DI const float* operator[](int i) const { return p->in[i]; } } in; };
constexpr int PH_PER_LAYER = 14, N_PHASES = 1 + PH_PER_LAYER * NLAYER;

__global__ void __launch_bounds__(512, 2) mk_fwd(Args a_) {
    extern __shared__ __attribute__((aligned(16))) unsigned char lds_raw[];
    LAS unsigned char* lds = (LAS unsigned char*)lds_raw;
    const int ph_lo = a_.ph_lo, ph_hi = a_.ph_hi;
#if !MK_PER_PHASE
    if (ph_hi < 0) cg::this_grid().sync();
    volatile LAS unsigned* bst = (volatile LAS unsigned*)(lds + 131072 + 64);
    if (threadIdx.x == 0) { bst[0] = 0u; bst[1] = 0u; }
    __syncthreads();
    const XcdBarrier gbar = xcd_barrier_post((unsigned*)(a_.ws + WS_CTL), bst);
#endif

    for (int ph = ph_lo; ph < ph_hi; ++ph) {
        const ArgsK* ap = (const ArgsK*)__builtin_amdgcn_kernarg_segment_ptr();
        int tid = threadIdx.x; asm volatile("" : "+v"(tid));
        int G = gridDim.x, bx = blockIdx.x; asm volatile("" : "+s"(G), "+s"(bx));
        const int lane = tid & 63, wid = __builtin_amdgcn_readfirstlane(tid >> 6);
        const int vcu = (G % 8 == 0) ? (bx % 8) * (G / 8) + bx / 8 : bx;
        const int gw = vcu * 8 + wid, NGW = G * 8;
        asm volatile("" : "+s"(ap));
        const ArgsV a = {ap, {ap}};
        unsigned char* ws = ap->ws;
        bf16_t* WB = (bf16_t*)(ws + WS_W);
        bf16_t* XB = (bf16_t*)(ws + WS_XB); float* SS = (float*)(ws + WS_SS); float* SSZ = (float*)(ws + WS_SSZ);
        bf16_t* MEMN = (bf16_t*)(ws + WS_MEMN); bf16_t* MKV = (bf16_t*)(ws + WS_MKV);
        bf16_t* H = (bf16_t*)(ws + WS_H); bf16_t* Z = (bf16_t*)(ws + WS_Z); bf16_t* QR = (bf16_t*)(ws + WS_QR);
        bf16_t* KVR = (bf16_t*)(ws + WS_KVR); bf16_t* OB = (bf16_t*)(ws + WS_O); bf16_t* KF = (bf16_t*)(ws + WS_KF);
        bf16_t* QM = (bf16_t*)(ws + WS_QM); bf16_t* OM = (bf16_t*)(ws + WS_OM);
        float* XR = ap->out;
        if (ph == 0) { if (!(PHMASK & 1)) continue;
            LAS float* scr = (LAS float*)(lds + wid * 16384);
            constexpr int I0 = 2816, I1 = 1408, I2 = 848, I3 = 96, I4 = 64, I5 = 512, I6 = 128, I7 = 256, I8 = 128, IL = I0 + I1 + I2 + I3 + I4 + I5 + I6 + I7 + I8 + I0 + I1;
            for (int it = gw; it < IL * NLAYER; it += NGW) {
                const int l = it / IL; int r = it % IL; bf16_t* wl = WB + (size_t)l * W_LAYER;
                if (r < I0) { wprep_item(a.in[3] + (size_t)l * 1024 * 5632, 1024, 5632, a.in[2] + l * 1024, wl + WO_F1IN, 1, scr, r, lane); continue; } r -= I0;
                if (r < I1) { wprep_item(a.in[4] + (size_t)l * 2816 * 1024, 2816, 1024, nullptr, wl + WO_F1OUT, 0, scr, r, lane); continue; } r -= I1;
                if (r < I2) { wprep_item(a.in[6] + (size_t)l * 1024 * 1696, 1024, 1696, a.in[5] + l * 1024, wl + WO_MIX, 2, scr, r, lane); continue; } r -= I2;
                if (r < I3) { wprep_item(a.in[8] + (size_t)l * 256 * 768, 256, 768, a.in[7] + l * 256, wl + WO_UQ, 0, scr, r, lane); continue; } r -= I3;
                if (r < I4) { wprep_item(a.in[10] + (size_t)l * 128 * 1024, 128, 1024, a.in[9] + l * 128, wl + WO_UKV, 0, scr, r, lane); continue; } r -= I4;
                if (r < I5) { wprep_item(a.in[20] + (size_t)l * 1024 * 1024, 1024, 1024, a.in[19] + l * 1024, wl + WO_MO, 0, scr, r, lane); continue; } r -= I5;
                if (r < I6) { wprep_item(a.in[23] + (size_t)l * 1024 * 256, 1024, 256, a.in[21] + l * 1024, wl + WO_MQ, 0, scr, r, lane); continue; } r -= I6;
                if (r < I7) { wprep_item(a.in[24] + (size_t)l * 1024 * 512, 1024, 512, a.in[22] + l * 1024, wl + WO_MKV, 0, scr, r, lane); continue; } r -= I7;
                if (r < I8) { wprep_item(a.in[27] + (size_t)l * 256 * 1024, 256, 1024, nullptr, wl + WO_MOUT, 0, scr, r, lane); continue; } r -= I8;
                if (r < I0) { wprep_item(a.in[29] + (size_t)l * 1024 * 5632, 1024, 5632, a.in[28] + l * 1024, wl + WO_F2IN, 1, scr, r, lane); continue; } r -= I0;
                wprep_item(a.in[30] + (size_t)l * 2816 * 1024, 2816, 1024, nullptr, wl + WO_F2OUT, 0, scr, r, lane);
            }
            for (int i = bx * 512 + tid; i < NLAYER * 96 * 1024 / 8; i += G * 512) { const int l = i / (96 * 128), r = i % (96 * 128);
                *(u32x4*)(WB + (size_t)l * W_LAYER + WO_MIX + (size_t)416 * 1024 + (size_t)r * 8) = (u32x4){0, 0, 0, 0}; }
            const float* x0 = a.in[0];
            for (int m = gw; m < M; m += 2 * NGW) {
                const int m2 = (m + NGW < M) ? m + NGW : m;
                const f32x4* xr = (const f32x4*)(x0 + (size_t)m * DM) + lane; const f32x4* xr2 = (const f32x4*)(x0 + (size_t)m2 * DM) + lane;
                f32x4 va[4], vb[4];
#pragma unroll
                for (int j = 0; j < 4; ++j) { va[j] = xr[64 * j]; vb[j] = xr2[64 * j]; }
                float s = 0.f, s2 = 0.f;
#pragma unroll
                for (int j = 0; j < 4; ++j) { s += (va[j].x * va[j].x + va[j].y * va[j].y) + (va[j].z * va[j].z + va[j].w * va[j].w); s2 += (vb[j].x * vb[j].x + vb[j].y * vb[j].y) + (vb[j].z * vb[j].z + vb[j].w * vb[j].w);
                    u32x2 w; w.x = pk2(va[j].x, va[j].y); w.y = pk2(va[j].z, va[j].w); *((u32x2*)(XB + (size_t)m * DM) + lane + 64 * j) = w;
                    w.x = pk2(vb[j].x, vb[j].y); w.y = pk2(vb[j].z, vb[j].w); *((u32x2*)(XB + (size_t)m2 * DM) + lane + 64 * j) = w; }
                s = wave_sum(s); s2 = wave_sum(s2);
                if (lane < 16) { SS[(size_t)m * 16 + lane] = (lane == 0) ? s : 0.f; SS[(size_t)m2 * 16 + lane] = (lane == 0) ? s2 : 0.f; }
            }
            for (int m = gw; m < BATCH * NMEM; m += NGW) {
                const f32x4* xr = (const f32x4*)(a.in[1] + (size_t)m * DM) + lane; f32x4 v[4]; float s = 0.f;
#pragma unroll
                for (int j = 0; j < 4; ++j) { v[j] = xr[64 * j]; s += (v[j].x * v[j].x + v[j].y * v[j].y) + (v[j].z * v[j].z + v[j].w * v[j].w); }
                const float rs = rsqrtf(wave_sum(s) * (1.0f / DM) + EPS);
#pragma unroll
                for (int j = 0; j < 4; ++j) { u32x2 w; w.x = pk2(v[j].x * rs, v[j].y * rs); w.y = pk2(v[j].z * rs, v[j].w * rs); *((u32x2*)(MEMN + (size_t)m * DM) + lane + 64 * j) = w; }
            }
        } else {
            const int l = (ph - 1) / PH_PER_LAYER, sp = (ph - 1) % PH_PER_LAYER;
            const bf16_t* wl = WB + (size_t)l * W_LAYER;
            pg8::StaticOrder SO;
            if (sp == 0 || sp == 11) { if (!(PHMASK & 2)) continue;
                pg8::Gemm g{XB, wl + (sp == 0 ? WO_F1IN : WO_F2IN), M, 5632, 1024, 1024, 1024}; SO.init(M, 5632, G, bx);
                pg8::EpiSwiGLU E{H, SS};
                pg8::gemm_phase(lds, g, SO, E);
                if (sp == 0 && l == 0) {
                    for (int l2 = 0; l2 < NLAYER; ++l2) {
                        pg8::Gemm g2{MEMN, WB + (size_t)l2 * W_LAYER + WO_MKV, BATCH * NMEM, 512, 1024, 1024, 1024}; SO.init(BATCH * NMEM, 512, G, (bx + 128 + 8 * l2) % G);
                        pg8::EpiScale<0> E2{MKV + (size_t)l2 * BATCH * NMEM * 512, 512, nullptr, nullptr};
                        pg8::gemm_phase(lds, g2, SO, E2);
                    }
                }
            } else if (sp == 1 || sp == 12) { if (!(PHMASK & 4)) continue;
                pg8::Gemm g{H, wl + (sp == 1 ? WO_F1OUT : WO_F2OUT), M, 1024, 2816, 2816, 2816}; SO.init(M, 1024, G, bx);
                pg8::EpiResid E{XB, SS, 0.5f};
                pg8::gemm_phase(lds, g, SO, E);
            } else if (sp == 2) { if (!(PHMASK & 8)) continue;
                pg8::Gemm g{XB, wl + WO_MIX, M, ZW, 1024, 1024, 1024}; SO.init(M, ZW, G, bx);
                pg8::EpiScale<1> E{Z, ZW, SS, SSZ};
                pg8::gemm_phase(lds, g, SO, E);
            } else if (sp == 3) { if (!(PHMASK & 16)) continue;
                { pg8::Gemm g{Z, wl + WO_UQ, M, 768, 256, ZW, 256}; SO.init(M, 768, G, bx);
                  pg8::EpiScale<2> E{QR, 768, SSZ, nullptr}; pg8::gemm_phase(lds, g, SO, E); }
                { pg8::Gemm g{Z + 256, wl + WO_UKV, M, 1024, 128, ZW, 128}; SO.init(M, 1024, G, bx);
                  pg8::EpiScale<3> E{KVR, 1024, SSZ, nullptr}; pg8::gemm_phase(lds, g, SO, E); }
            } else if (sp == 4) { if (!(PHMASK & 32)) continue;
                const float* kgain = a.in[12] + l * 96;
                for (int m = gw; m < M; m += NGW) {
                    const int bb = m / SEQ, s = m % SEQ, hh = lane >> 3, sub = lane & 7;
                    float f[16]; float ss = 0.f; float x1[4], x2[4];
                    if (sub < 4) {
                        const u32x4 w0 = *(const u32x4*)(KVR + (size_t)m * 1024 + hh * 128 + sub * 16), w1 = *(const u32x4*)(KVR + (size_t)m * 1024 + hh * 128 + sub * 16 + 8);
                        float t0[8], t1[8]; unpack8(w0, t0); unpack8(w1, t1);
#pragma unroll
                        for (int j = 0; j < 8; ++j) { f[j] = t0[j]; f[8 + j] = t1[j]; ss += t0[j] * t0[j] + t1[j] * t1[j]; }
                    } else {
                        const int i0 = 4 * (sub - 4);
                        const u32x2 wa = *(const u32x2*)(Z + (size_t)m * ZW + 384 + i0), wb = *(const u32x2*)(Z + (size_t)m * ZW + 400 + i0);
                        x1[0] = bf_lo(wa.x); x1[1] = bf_hi(wa.x); x1[2] = bf_lo(wa.y); x1[3] = bf_hi(wa.y);
                        x2[0] = bf_lo(wb.x); x2[1] = bf_hi(wb.x); x2[2] = bf_lo(wb.y); x2[3] = bf_hi(wb.y);
#pragma unroll
                        for (int j = 0; j < 4; ++j) ss += x1[j] * x1[j] + x2[j] * x2[j];
#pragma unroll
                        for (int j = 0; j < 16; ++j) f[j] = 0.f;
                    }
                    ss += __shfl_xor(ss, 1); ss += __shfl_xor(ss, 2); ss += __shfl_xor(ss, 4);
                    const float rs = rsqrtf(ss * (1.0f / 96.0f) + EPS);
                    bf16_t* kdst = KF + ((size_t)(bb * 8 + hh) * SEQ + s) * 96;
                    if (sub < 4) {
                        float o0[8], o1[8];
#pragma unroll
                        for (int j = 0; j < 8; ++j) { o0[j] = f[j] * rs * kgain[sub * 16 + j]; o1[j] = f[8 + j] * rs * kgain[sub * 16 + 8 + j]; }
                        *(u32x4*)(kdst + sub * 16) = pack8(o0); *(u32x4*)(kdst + sub * 16 + 8) = pack8(o1);
                    } else {
                        const int i0 = 4 * (sub - 4); float y1[4], y2[4];
#pragma unroll
                        for (int j = 0; j < 4; ++j) { float c, sn; rope_cs(s, i0 + j, c, sn);
                            const float aa = x1[j] * rs * kgain[64 + i0 + j], bb2 = x2[j] * rs * kgain[80 + i0 + j];
                            y1[j] = aa * c - bb2 * sn; y2[j] = aa * sn + bb2 * c; }
                        u32x2 w; w.x = pk2(y1[0], y1[1]); w.y = pk2(y1[2], y1[3]); *(u32x2*)(kdst + 64 + i0) = w;
                        w.x = pk2(y2[0], y2[1]); w.y = pk2(y2[2], y2[3]); *(u32x2*)(kdst + 80 + i0) = w;
                    }
                }
            } else if (sp == 5) { if (!(PHMASK & 64)) continue;
                { AttnP P{QR, 768, 0, KF, KVR, OB, 1024, 0, a.in[11] + l * 96, nullptr, nullptr, nullptr};
                  const float* qgp = a.in[11] + l * 96; const float* kgp = a.in[12] + l * 96;
                  float gq = fmaxf(fabsf(qgp[lane]), (lane < 32) ? fabsf(qgp[64 + lane]) : 0.f), gk = fmaxf(fabsf(kgp[lane]), (lane < 32) ? fabsf(kgp[64 + lane]) : 0.f);
#pragma unroll
                  for (int o = 1; o < 64; o <<= 1) { gq = fmaxf(gq, __shfl_xor(gq, o)); gk = fmaxf(gk, __shfl_xor(gk, o)); }
                  const float Bnd = 9.797958971f * LOG2E * 1.02f * gq * gk;
                  if (G == 256 && Bnd <= 20.0f) {
                      for (int i = 0; i < 4; ++i) { const int bh = (vcu >> 5) * 4 + i, qb = vcu & 31; mla_unit_fast(P, bh >> 3, bh & 7, qb, lds); }
                  } else if (G == 256) {
                      for (int i = 0; i < 4; ++i) { const int bh = (vcu >> 5) * 4 + i, qb = vcu & 31; mla_unit(P, bh >> 3, bh & 7, qb, lds); }
                  } else {
                      for (int U = vcu; U < 1024; U += G) { const int bh = (U & 255) >> 3, qb = (U & 7) | ((U >> 8) << 3); mla_unit(P, bh >> 3, bh & 7, qb, lds); }
                  } }
#ifndef ONLY_MLA
                { AttnP P{Z, ZW, 512, Z + 768, Z + 896, OB, 1024, 512, a.in[13] + l * 64, a.in[14] + l * 64, a.in[15] + l * 4, nullptr};
                  for (int U = vcu; U < 512; U += G) attn_unit<AT_SWA>(P, U >> 7, (U >> 5) & 3, U & 31, lds); }
                { AttnP P{Z, ZW, 1024, Z + 1280, Z + 1536, OB, 1024, 768, a.in[16] + l * 64, a.in[17] + l * 64, nullptr, a.in[18] + (size_t)l * 4 * 465};
                  for (int U = vcu; U < 512; U += G) attn_unit<AT_NA>(P, U >> 7, (U >> 5) & 3, U & 31, lds); }
#endif
            } else if (sp == 6) { if (!(PHMASK & 128)) continue;
                for (int m = gw; m < M; m += 4 * NGW) {
                    u32x4 w[4][2];
#pragma unroll
                    for (int r = 0; r < 4; ++r) { const int mr = (m + r * NGW < M) ? m + r * NGW : m; const bf16_t* orow = OB + (size_t)mr * 1024 + lane * 16;
                        w[r][0] = *(const u32x4*)orow; w[r][1] = *(const u32x4*)(orow + 8); }
#pragma unroll
                    for (int r = 0; r < 4; ++r) { if (r > 0 && m + r * NGW >= M) continue; const int mr = m + r * NGW; bf16_t* orow = OB + (size_t)mr * 1024 + lane * 16;
                        float t0[8], t1[8]; unpack8(w[r][0], t0); unpack8(w[r][1], t1); float ss = 0.f;
#pragma unroll
                        for (int j = 0; j < 8; ++j) ss += t0[j] * t0[j] + t1[j] * t1[j];
                        ss += __shfl_xor(ss, 1); ss += __shfl_xor(ss, 2); ss += __shfl_xor(ss, 4); ss += __shfl_xor(ss, 8);
                        const float so = __shfl_xor(ss, 16);
                        if (lane < 32) ss += so;
                        const float rs = rsqrtf(ss * ((lane < 32) ? (1.0f / 512.0f) : (1.0f / 256.0f)) + EPS);
#pragma unroll
                        for (int j = 0; j < 8; ++j) { t0[j] *= rs; t1[j] *= rs; }
                        *(u32x4*)orow = pack8(t0); *(u32x4*)(orow + 8) = pack8(t1); }
                }
            } else if (sp == 7) { if (!(PHMASK & 256)) continue;
                pg8::Gemm g{OB, wl + WO_MO, M, 1024, 1024, 1024, 1024}; SO.init(M, 1024, G, bx);
                pg8::EpiResid E{XB, SS, 1.0f};
                pg8::gemm_phase(lds, g, SO, E);
            } else if (sp == 8) { if (!(PHMASK & 512)) continue;
                pg8::Gemm g{XB, wl + WO_MQ, M, 256, 1024, 1024, 1024}; SO.init(M, 256, G, bx);
                pg8::EpiScale<1> E{QM, 256, SS, nullptr};
                pg8::gemm_phase(lds, g, SO, E);
            } else if (sp == 9) { if (!(PHMASK & 1024)) continue;
                const bf16_t* mkv = MKV + (size_t)l * BATCH * NMEM * 512;
                AttnP P{QM, 256, 0, mkv, mkv, OM, 256, 0, a.in[25] + l * 64, a.in[26] + l * 64, nullptr, nullptr};
                for (int U = vcu; U < 512; U += G) attn_unit<AT_MEM>(P, U >> 7, (U >> 5) & 3, U & 31, lds);
            } else if (sp == 10) { if (!(PHMASK & 2048)) continue;
                pg8::Gemm g{OM, wl + WO_MOUT, M, 1024, 256, 256, 256}; SO.init(M, 1024, G, bx);
                pg8::EpiResid E{XB, SS, 1.0f};
                pg8::gemm_phase(lds, g, SO, E);
            } else if (sp == 13) {
                const float* gn = a.in[31] + l * 1024; const bool lastl = (l == NLAYER - 1);
                const f32x4 g0 = *(const f32x4*)(gn + lane * 16), g1 = *(const f32x4*)(gn + lane * 16 + 4), g2 = *(const f32x4*)(gn + lane * 16 + 8), g3 = *(const f32x4*)(gn + lane * 16 + 12);
                for (int m = gw; m < M; m += 4 * NGW) {
                    u32x4 w[4][2];
#pragma unroll
                    for (int r = 0; r < 4; ++r) { const int mr = (m + r * NGW < M) ? m + r * NGW : m; const bf16_t* xrow = XB + (size_t)mr * DM + lane * 16;
                        w[r][0] = *(const u32x4*)xrow; w[r][1] = *(const u32x4*)(xrow + 8); }
#pragma unroll
                    for (int r = 0; r < 4; ++r) { if (r > 0 && m + r * NGW >= M) continue; const int mr = m + r * NGW; bf16_t* xrow = XB + (size_t)mr * DM + lane * 16;
                        float t0[8], t1[8]; unpack8(w[r][0], t0); unpack8(w[r][1], t1); float s = 0.f;
#pragma unroll
                        for (int j = 0; j < 8; ++j) s += t0[j] * t0[j] + t1[j] * t1[j];
                        const float rs = rsqrtf(wave_sum(s) * (1.0f / DM) + EPS); float s2 = 0.f;
#pragma unroll
                        for (int j = 0; j < 4; ++j) { t0[j] *= rs * g0[j]; t0[4 + j] *= rs * g1[j]; t1[j] *= rs * g2[j]; t1[4 + j] *= rs * g3[j]; }
#pragma unroll
                        for (int j = 0; j < 8; ++j) s2 += t0[j] * t0[j] + t1[j] * t1[j];
                        if (lastl) {
                            float* orow = XR + (size_t)mr * DM + lane * 16;
                            *(f32x4*)orow = (f32x4){t0[0], t0[1], t0[2], t0[3]}; *(f32x4*)(orow + 4) = (f32x4){t0[4], t0[5], t0[6], t0[7]};
                            *(f32x4*)(orow + 8) = (f32x4){t1[0], t1[1], t1[2], t1[3]}; *(f32x4*)(orow + 12) = (f32x4){t1[4], t1[5], t1[6], t1[7]};
                        } else {
                            *(u32x4*)xrow = pack8(t0); *(u32x4*)(xrow + 8) = pack8(t1);
                            s2 = wave_sum(s2);
                            if (lane < 16) SS[(size_t)mr * 16 + lane] = (lane == 0) ? s2 : 0.f;
                        } }
                }
            }
        }
#if !MK_PER_PHASE
        if (ph + 1 < ph_hi) xcd_barrier(gbar);
#endif
    }
}

extern "C" void kernel_launch(void* const* d_in, const int* in_sizes, int n_in, void* d_out, int out_size, void* d_ws, size_t ws_size, hipStream_t stream) {
    static int grid = 0;
    if (grid == 0) {
        if (n_in != 32 || out_size != M * DM || ws_size < WS_END) { fprintf(stderr, "kernel_launch: unexpected shapes (n_in %d, out %d, ws %zu)\n", n_in, out_size, ws_size); grid = -1; return; }
        int dev = 0, cus = 0, per_cu = 0;
        hipGetDevice(&dev);
        hipDeviceGetAttribute(&cus, hipDeviceAttributeMultiprocessorCount, dev);
        hipFuncSetAttribute((const void*)mk_fwd, hipFuncAttributeMaxDynamicSharedMemorySize, LDS_BYTES);
        hipOccupancyMaxActiveBlocksPerMultiprocessor(&per_cu, (const void*)mk_fwd, 512, LDS_BYTES);
        if (per_cu < 1) { fprintf(stderr, "kernel_launch: occupancy query gave %d\n", per_cu); per_cu = 1; }
        (void)hipGetLastError();
        grid = cus * per_cu;
    }
    if (grid < 0) return;
    if (hipMemsetAsync((char*)d_ws + WS_CTL, 0, CTL_BYTES, stream) != hipSuccess) { fprintf(stderr, "kernel_launch: memset of barrier words failed\n"); return; }
    Args a{};
    for (int i = 0; i < 32; ++i) a.in[i] = (const float*)d_in[i];
    a.out = (float*)d_out; a.ws = (unsigned char*)d_ws;
#if MK_PER_PHASE
    for (int ph = 0; ph < N_PHASES; ++ph) { a.ph_lo = ph; a.ph_hi = ph + 1; hipLaunchKernelGGL(mk_fwd, dim3(grid), dim3(512), LDS_BYTES, stream, a); }
#else
    a.ph_lo = 0; a.ph_hi = N_PHASES;
    void* args[] = {&a};
    hipError_t e = hipLaunchCooperativeKernel((const void*)mk_fwd, dim3(grid), dim3(512), args, LDS_BYTES, stream);
    if (e != hipSuccess) fprintf(stderr, "cooperative launch failed: %s (grid %d)\n", hipGetErrorString(e), grid);
#endif
}
```

```cpp
#include <hip/hip_runtime.h>
#include <hip/hip_cooperative_groups.h>
#include <cstdio>
#include <cstdint>
namespace cg = cooperative_groups;

#ifndef MK_PER_PHASE
#define MK_PER_PHASE 0
#endif

#ifndef PHMASK
#define PHMASK 0xffff
#endif
#define LAS __attribute__((address_space(3)))
#define DI __device__ __forceinline__
typedef unsigned short bf16_t;
typedef short bf16x8 __attribute__((ext_vector_type(8)));
typedef short s16x4 __attribute__((ext_vector_type(4)));
typedef float f32x2 __attribute__((ext_vector_type(2)));
typedef float f32x4 __attribute__((ext_vector_type(4)));
typedef float f32x16 __attribute__((ext_vector_type(16)));
typedef unsigned u32x2 __attribute__((ext_vector_type(2)));
typedef unsigned u32x4 __attribute__((ext_vector_type(4)));
typedef __bf16 bf16x2_t __attribute__((ext_vector_type(2)));

constexpr int BATCH = 4, SEQ = 8192, DM = 1024, NLAYER = 2, M = BATCH * SEQ, NMEM = 256, DFF = 2816;
constexpr int ZW = 1792;
constexpr float EPS = 1e-6f, LOG2E = 1.4426950408889634f;

constexpr size_t MiB = 1u << 20;
constexpr size_t WO_F1IN = 0, WO_F1OUT = WO_F1IN + (size_t)5632 * 1024, WO_MIX = WO_F1OUT + (size_t)1024 * 2816, WO_UQ = WO_MIX + (size_t)ZW * 1024,
                 WO_UKV = WO_UQ + (size_t)768 * 256, WO_MO = WO_UKV + (size_t)1024 * 128, WO_MQ = WO_MO + (size_t)1024 * 1024, WO_MKV = WO_MQ + (size_t)256 * 1024,
                 WO_MOUT = WO_MKV + (size_t)512 * 1024, WO_F2IN = WO_MOUT + (size_t)1024 * 256, WO_F2OUT = WO_F2IN + (size_t)5632 * 1024, W_LAYER = WO_F2OUT + (size_t)1024 * 2816;
static_assert(W_LAYER * 2 * NLAYER <= 84 * MiB, "weights fit");
constexpr size_t WS_W = 0, WS_XB = 84 * MiB, WS_SS = 148 * MiB, WS_SSZ = 150 * MiB, WS_MEMN = 152 * MiB, WS_MKV = 154 * MiB,
                 WS_H = 156 * MiB, WS_Z = 156 * MiB, WS_QR = 268 * MiB, WS_KVR = 332 * MiB, WS_KF = 396 * MiB,
                 WS_QM = 396 * MiB, WS_OM = 412 * MiB, WS_O = 444 * MiB, WS_END = 508 * MiB, WS_CTL = 83 * MiB, CTL_BYTES = 16384;
static_assert(WS_H + (size_t)M * DFF * 2 <= WS_KVR && WS_Z + (size_t)M * ZW * 2 <= WS_QR && WS_QR + (size_t)M * 768 * 2 <= WS_KVR, "ws map");

constexpr int LDS_BYTES = 147456;

DI float bf_lo(unsigned w) { return __uint_as_float(w << 16); }
DI float bf_hi(unsigned w) { return __uint_as_float(w & 0xffff0000u); }
DI unsigned pk2(float lo, float hi) { f32x2 v = {lo, hi}; bf16x2_t b = __builtin_convertvector(v, bf16x2_t); return __builtin_bit_cast(unsigned, b); }
DI float wave_sum(float v) {
#pragma unroll
    for (int o = 1; o < 64; o <<= 1) v += __shfl_xor(v, o);
    return v;
}
DI void unpack8(const u32x4 w, float (&f)[8]) {
    f[0] = bf_lo(w.x); f[1] = bf_hi(w.x); f[2] = bf_lo(w.y); f[3] = bf_hi(w.y); f[4] = bf_lo(w.z); f[5] = bf_hi(w.z); f[6] = bf_lo(w.w); f[7] = bf_hi(w.w);
}
DI u32x4 pack8(const float (&f)[8]) { u32x4 w; w.x = pk2(f[0], f[1]); w.y = pk2(f[2], f[3]); w.z = pk2(f[4], f[5]); w.w = pk2(f[6], f[7]); return w; }
DI void rope_cs(int pos, int i, float& c, float& s) {
    const float inv = exp2f(-(float)i * (13.287712379549449f / 16.0f));
    const float ang = (float)pos * inv;
    float rev = ang * 0.15915494309189535f; rev = rev - floorf(rev);
    s = __builtin_amdgcn_sinf(rev); c = __builtin_amdgcn_cosf(rev);
}

namespace pg8 {
constexpr int BM = 256, BK = 64, HALF = 128, HTB = HALF * BK * 2, STAGE_BYTES = 8 * HTB, NXCD = 8, WGM = 8;
DI int lds_byte(int r, int c) { const int st = (r >> 4) * 2 + (c >> 5), rr = r & 15, cc = c & 31, ob = rr * 64 + cc * 2; return st * 1024 + (ob ^ (((ob >> 9) & 1) << 5)); }
DI void stage_rc(int b, int& R, int& C) { const int st = b / 1024, sb = b % 1024, swz = sb ^ (((sb >> 9) & 1) << 5); R = (st >> 1) * 16 + swz / 64; C = (st & 1) * 32 + (swz % 64) / 2; }
DI int perm32(int rho) { const int n = rho >> 4, i = rho & 15; return 8 * (i >> 2) + 4 * n + (i & 3); }

struct Unit { int pm, pn; };
struct Gemm { const bf16_t* A; const bf16_t* Bt; int M, N, K, lda, ldb; };

struct StaticOrder {
    int nM, nN, nwg, G, c;
    DI void init(int M_, int N_, int G_, int c_) { nM = M_ / BM; nN = N_ / BM; nwg = nM * nN; G = G_; c = c_; }
    DI bool next(int i, Unit& u) const {
        const long L = (long)i * G + c; if (L >= nwg) return false;
        int wgid = (int)L; { const int q = nwg / NXCD, r = nwg % NXCD, xcd = wgid % NXCD, off = wgid / NXCD; wgid = (xcd < r ? xcd * (q + 1) : r * (q + 1) + (xcd - r) * q) + off; }
        const int nig = WGM * nN, gid = wgid / nig, fm = gid * WGM, gsz = (nM - fm) < WGM ? (nM - fm) : WGM;
        u.pm = fm + ((wgid % nig) % gsz); u.pn = (wgid % nig) / gsz; return true;
    }
};

DI float rstd_from16(const float* SS, size_t row, int fq) {
    const f32x4 v = *(const f32x4*)(SS + row * 16 + 4 * fq); float s = (v.x + v.y) + (v.z + v.w);
    s += __shfl_xor(s, 16); s += __shfl_xor(s, 32); return rsqrtf(s * (1.0f / 1024.0f) + EPS);
}
struct EpiSwiGLU {
    static constexpr bool PERM = true, KSCALE = false;
    bf16_t* H; const float* SS;
    DI void operator()(const f32x4 (&acc)[2][2][4][2], const Unit& u, int wr, int wc, int fr, int fq) const {
        const int col0 = u.pn * 128 + wc * 32 + 8 * fq;
#pragma unroll
        for (int ai = 0; ai < 2; ++ai)
#pragma unroll
            for (int m = 0; m < 4; ++m) {
                const size_t row = (size_t)u.pm * BM + ai * HALF + wr * 64 + m * 16 + fr;
                const float rs = rstd_from16(SS, row, fq);
                float hv[8];
#pragma unroll
                for (int n = 0; n < 2; ++n)
#pragma unroll
                    for (int e = 0; e < 4; ++e) {
                        const float g = acc[ai][0][m][n][e] * rs, uu = acc[ai][1][m][n][e] * rs;
                        const float sg = g * __builtin_amdgcn_rcpf(1.0f + __builtin_amdgcn_exp2f(-g * LOG2E));
                        hv[n * 4 + e] = sg * uu;
                    }
                *(u32x4*)(H + row * DFF + col0) = pack8(hv);
            }
    }
};
struct EpiResid {
    static constexpr bool PERM = true, KSCALE = false;
    bf16_t* xb; float* SS; float alpha;
    DI void operator()(const f32x4 (&acc)[2][2][4][2], const Unit& u, int wr, int wc, int fr, int fq) const {
        const int col0 = u.pn * BM + wc * 32 + 8 * fq;
#pragma unroll
        for (int ai = 0; ai < 2; ++ai) {
            u32x4 pre[4][2];
#pragma unroll
            for (int m = 0; m < 4; ++m)
#pragma unroll
                for (int bj = 0; bj < 2; ++bj)
                    pre[m][bj] = *(const u32x4*)(xb + ((size_t)u.pm * BM + ai * HALF + wr * 64 + m * 16 + fr) * DM + col0 + bj * HALF);
#pragma unroll
            for (int m = 0; m < 4; ++m) {
                const size_t row = (size_t)u.pm * BM + ai * HALF + wr * 64 + m * 16 + fr;
                float ss = 0.f;
#pragma unroll
                for (int bj = 0; bj < 2; ++bj) {
                    float v[8]; unpack8(pre[m][bj], v);
#pragma unroll
                    for (int n = 0; n < 2; ++n)
#pragma unroll
                        for (int e = 0; e < 4; ++e) { v[n * 4 + e] += acc[ai][bj][m][n][e] * alpha; ss += v[n * 4 + e] * v[n * 4 + e]; }
                    *(u32x4*)(xb + row * DM + col0 + bj * HALF) = pack8(v);
                }
                ss += __shfl_xor(ss, 16); ss += __shfl_xor(ss, 32);
                if (fq == 0) SS[row * 16 + u.pn * 4 + wc] = ss;
            }
        }
    }
};
struct EpiResidKS {
    static constexpr bool PERM = true, KSCALE = true;
    bf16_t* xb; float* SS; float alpha; const float* sso;
    DI void kscale(f32x4 (&acc)[2][2][4][2], const Unit& u, int wr, int fr, int fq, int seg) const {
        const float* sp = sso + ((size_t)u.pm * BM + wr * 64 + fr) * 16 + 4 * fq;
#pragma unroll
        for (int ai = 0; ai < 2; ++ai)
#pragma unroll
            for (int m = 0; m < 4; ++m) {
                const f32x4 v = *(const f32x4*)(sp + (ai * HALF + m * 16) * 16); const float s = (v.x + v.y) + (v.z + v.w);
                float num, den;
                if (seg == 0) { num = (__shfl(s, fr) + __shfl(s, fr + 16)) * (1.0f / 512.0f); den = __shfl(s, fr + 32) * (1.0f / 256.0f); }
                else          { num = __shfl(s, fr + 32) * (1.0f / 256.0f); den = __shfl(s, fr + 48) * (1.0f / 256.0f); }
                const float f = rsqrtf(num + EPS) * __builtin_amdgcn_sqrtf(den + EPS);
#pragma unroll
                for (int bj = 0; bj < 2; ++bj)
#pragma unroll
                    for (int n = 0; n < 2; ++n) acc[ai][bj][m][n] = acc[ai][bj][m][n] * f;
                asm volatile("" ::: "memory");
            }
    }
    DI void operator()(const f32x4 (&acc)[2][2][4][2], const Unit& u, int wr, int wc, int fr, int fq) const {
        const float* sp = sso + ((size_t)u.pm * BM + wr * 64 + fr) * 16 + 4 * fq;
        bf16_t* xp = xb + ((size_t)u.pm * BM + wr * 64 + fr) * DM + u.pn * BM + wc * 32 + 8 * fq;
        float* ssp = SS + ((size_t)u.pm * BM + wr * 64 + fr) * 16 + u.pn * 4 + wc;
#pragma unroll
        for (int ai = 0; ai < 2; ++ai) {
            u32x4 pre[4][2]; float sg[4];
#pragma unroll
            for (int m = 0; m < 4; ++m) {
#pragma unroll
                for (int bj = 0; bj < 2; ++bj) pre[m][bj] = *(const u32x4*)(xp + (ai * HALF + m * 16) * DM + bj * HALF);
                const f32x4 v = *(const f32x4*)(sp + (ai * HALF + m * 16) * 16); sg[m] = (v.x + v.y) + (v.z + v.w);
            }
#pragma unroll
            for (int m = 0; m < 4; ++m) {
                const float sc = alpha * rsqrtf(__shfl(sg[m], fr + 48) * (1.0f / 256.0f) + EPS); float ss = 0.f;
#pragma unroll
                for (int bj = 0; bj < 2; ++bj) {
                    float v[8]; unpack8(pre[m][bj], v);
#pragma unroll
                    for (int n = 0; n < 2; ++n)
#pragma unroll
                        for (int e = 0; e < 4; ++e) { v[n * 4 + e] += acc[ai][bj][m][n][e] * sc; ss += v[n * 4 + e] * v[n * 4 + e]; }
                    *(u32x4*)(xp + (ai * HALF + m * 16) * DM + bj * HALF) = pack8(v);
                }
                ss += __shfl_xor(ss, 16); ss += __shfl_xor(ss, 32);
                if (fq == 0) ssp[(ai * HALF + m * 16) * 16] = ss;
            }
        }
    }
};
template <int MODE> struct EpiScale {
    static constexpr bool PERM = true, KSCALE = false;
    bf16_t* O; int ldc; const float* ssrc; float* part;
    DI void operator()(const f32x4 (&acc)[2][2][4][2], const Unit& u, int wr, int wc, int fr, int fq) const {
        const int col0 = u.pn * BM + wc * 32 + 8 * fq;
#pragma unroll
        for (int ai = 0; ai < 2; ++ai)
#pragma unroll
            for (int m = 0; m < 4; ++m) {
                const size_t row = (size_t)u.pm * BM + ai * HALF + wr * 64 + m * 16 + fr;
                float rs = 1.0f;
                if constexpr (MODE == 1) rs = rstd_from16(ssrc, row, fq);
                if constexpr (MODE == 2) { const f32x2 v = *(const f32x2*)(ssrc + row * 16 + 2 * fq); float s = v.x + v.y; s += __shfl_xor(s, 16); s += __shfl_xor(s, 32); rs = rsqrtf(s * (1.0f / 256.0f) + EPS); }
                if constexpr (MODE == 3) { float s = ssrc[row * 16 + 8 + fq]; s += __shfl_xor(s, 16); s += __shfl_xor(s, 32); rs = rsqrtf(s * (1.0f / 128.0f) + EPS); }
#pragma unroll
                for (int bj = 0; bj < 2; ++bj) {
                    float v[8]; float ss = 0.f;
#pragma unroll
                    for (int n = 0; n < 2; ++n)
#pragma unroll
                        for (int e = 0; e < 4; ++e) { v[n * 4 + e] = acc[ai][bj][m][n][e] * rs; ss += v[n * 4 + e] * v[n * 4 + e]; }
                    *(u32x4*)(O + row * ldc + col0 + bj * HALF) = pack8(v);
                    if (part != nullptr && u.pn < 2) { ss += __shfl_xor(ss, 16); ss += __shfl_xor(ss, 32); if (fq == 0) part[row * 16 + u.pn * 8 + bj * 4 + wc] = ss; }
                }
            }
    }
};

template <class Epi>
DI void gemm_phase(LAS unsigned char* lds, const Gemm g, const StaticOrder& S, const Epi& E) {
    int tid = threadIdx.x; asm volatile("" : "+v"(tid));
    const int wid = __builtin_amdgcn_readfirstlane(tid >> 6), lane = tid & 63, wr = wid >> 2, wc = wid & 3, fr = lane & 15, fq = lane >> 4;
    int nt = g.K / BK; asm volatile("" : "+s"(nt));
    unsigned voffA[2], voffB[2];
#pragma unroll
    for (int i = 0; i < 2; ++i) { int R, C; stage_rc(tid * 16 + i * 8192, R, C); const int Rb = Epi::PERM ? ((R & ~31) + perm32(R & 31)) : R;
        voffA[i] = (unsigned)(R * g.lda + C) * 2u; voffB[i] = (unsigned)(Rb * g.ldb + C) * 2u; }
    const size_t kstep = (size_t)(BK * 2);
    const size_t hstepA = (size_t)HALF * g.lda * 2, hstepB = (size_t)HALF * g.ldb * 2;
    const size_t tstepA = 2 * hstepA, tstepB = 2 * hstepB;
    const unsigned ldsw = (unsigned)wid * 1024u;
    const int aoff = lds_byte(wr * 64 + fr, fq * 8), boff = lds_byte(wc * 32 + fr, fq * 8);
#define PG8_SA(b, h) (((b) * 2 + (h)) * HTB)
#define PG8_SB(b, h) ((4 + (b) * 2 + (h)) * HTB)
#define PG8_STAGE(bufoff, gbase, voff) do { _Pragma("unroll") for (int _i = 0; _i < 2; ++_i) \
        __builtin_amdgcn_global_load_lds((const unsigned*)((const char*)(gbase) + (voff)[_i]), (LAS unsigned*)(lds + (bufoff) + ldsw + _i * 8192), 16, 0, 0); } while (0)
#define PG8_LDA(dst, b, h) do { _Pragma("unroll") for (int m = 0; m < 4; ++m) _Pragma("unroll") for (int k = 0; k < 2; ++k) dst[m][k] = *(const LAS bf16x8*)(lds + PG8_SA(b, h) + aoff + m * 2048 + k * 1024); } while (0)
#define PG8_LDB(dst, b, h) do { _Pragma("unroll") for (int n = 0; n < 2; ++n) _Pragma("unroll") for (int k = 0; k < 2; ++k) dst[n][k] = *(const LAS bf16x8*)(lds + PG8_SB(b, h) + boff + n * 2048 + k * 1024); } while (0)
#define PG8_MMA(ai, bj, At, Bt) do { __builtin_amdgcn_s_setprio(1); _Pragma("unroll") for (int m = 0; m < 4; ++m) _Pragma("unroll") for (int n = 0; n < 2; ++n) _Pragma("unroll") for (int k = 0; k < 2; ++k) \
        acc[ai][bj][m][n] = __builtin_amdgcn_mfma_f32_16x16x32_bf16(Bt[n][k], At[m][k], acc[ai][bj][m][n], 0, 0, 0); __builtin_amdgcn_s_setprio(0); } while (0)
#define PG8_WAIT_V(n) asm volatile("s_waitcnt vmcnt(" #n ")" ::: "memory")
#define PG8_WAIT_L(n) asm volatile("s_waitcnt lgkmcnt(" #n ")" ::: "memory")
#define PG8_BAR __builtin_amdgcn_s_barrier()
#define PG8_SCHED __builtin_amdgcn_sched_barrier(0)
    Unit cur, nxt; int ui = 0;
    if (!S.next(0, cur)) return;
    f32x4 acc[2][2][4][2];
#pragma unroll
    for (int a = 0; a < 2; ++a)
#pragma unroll
        for (int b = 0; b < 2; ++b)
#pragma unroll
            for (int m = 0; m < 4; ++m)
#pragma unroll
                for (int n = 0; n < 2; ++n) acc[a][b][m][n] = (f32x4){0.f, 0.f, 0.f, 0.f};
    bf16x8 At[4][2], B0[2][2], B1[2][2];
    const char* cA = (const char*)g.A + (size_t)cur.pm * tstepA; const char* cB = (const char*)g.Bt + (size_t)cur.pn * tstepB;
    PG8_STAGE(PG8_SB(0, 0), cB, voffB); PG8_STAGE(PG8_SB(0, 1), cB + hstepB, voffB); PG8_STAGE(PG8_SA(0, 0), cA, voffA); PG8_STAGE(PG8_SA(0, 1), cA + hstepA, voffA);
    if (wr == 1) PG8_BAR;
    PG8_WAIT_V(2); PG8_BAR;
    PG8_STAGE(PG8_SB(1, 0), cB + kstep, voffB); PG8_STAGE(PG8_SA(1, 0), cA + kstep, voffA); PG8_STAGE(PG8_SB(1, 1), cB + hstepB + kstep, voffB);
    PG8_WAIT_V(6); PG8_BAR;
    for (;;) {
        const bool has_next = S.next(ui + 1, nxt);
        const char* nA = has_next ? (const char*)g.A + (size_t)nxt.pm * tstepA : cA; const char* nB = has_next ? (const char*)g.Bt + (size_t)nxt.pn * tstepB : cB;
        int tb_ = 0;
        for (int seg_ = 0; ; ++seg_) {
        int te_ = nt; if constexpr (Epi::KSCALE) { asm volatile("" : "+s"(seg_)); te_ = (seg_ == 0) ? 8 : (seg_ == 1) ? 12 : nt; }
        for (int t = tb_; t < te_; t += 2) {
            const bool last = (t == nt - 2);
            const char* a1 = cA + (size_t)(t + 1) * kstep;
            const char* a2 = last ? nA : cA + (size_t)(t + 2) * kstep; const char* b2 = last ? nB : cB + (size_t)(t + 2) * kstep;
            const char* a3 = a2 + kstep; const char* b3 = b2 + kstep;
            PG8_LDB(B0, 0, 0); PG8_LDB(B1, 0, 1); PG8_SCHED; PG8_LDA(At, 0, 0); PG8_STAGE(PG8_SA(1, 1), a1 + hstepA, voffA);
            PG8_WAIT_V(8); PG8_WAIT_L(0); PG8_BAR; PG8_MMA(0, 0, At, B0); PG8_MMA(0, 1, At, B1); PG8_BAR; PG8_SCHED;
            PG8_LDA(At, 0, 1); PG8_STAGE(PG8_SB(0, 0), b2, voffB); PG8_STAGE(PG8_SB(0, 1), b2 + hstepB, voffB); PG8_STAGE(PG8_SA(0, 0), a2, voffA);
            PG8_WAIT_V(8); PG8_WAIT_L(0); PG8_BAR; PG8_MMA(1, 0, At, B0); PG8_MMA(1, 1, At, B1); PG8_BAR; PG8_SCHED;
            PG8_LDB(B0, 1, 0); PG8_LDB(B1, 1, 1); PG8_SCHED; PG8_LDA(At, 1, 0); PG8_STAGE(PG8_SA(0, 1), a2 + hstepA, voffA);
            PG8_WAIT_V(8); PG8_WAIT_L(0); PG8_BAR; PG8_MMA(0, 0, At, B0); PG8_MMA(0, 1, At, B1); PG8_BAR; PG8_SCHED;
            PG8_LDA(At, 1, 1); PG8_STAGE(PG8_SB(1, 0), b3, voffB); PG8_STAGE(PG8_SB(1, 1), b3 + hstepB, voffB); PG8_STAGE(PG8_SA(1, 0), a3, voffA);
            PG8_WAIT_V(8); PG8_WAIT_L(0); PG8_BAR; PG8_MMA(1, 0, At, B0); PG8_MMA(1, 1, At, B1); PG8_BAR; PG8_SCHED;
        }
        if constexpr (Epi::KSCALE) { if (seg_ < 2) { E.kscale(acc, cur, wr, fr, fq, seg_); tb_ = te_; continue; } }
        break;
        }
        if (wr == 0) PG8_BAR;
        E(acc, cur, wr, wc, fr, fq);
        if (!has_next) break;
#pragma unroll
        for (int a = 0; a < 2; ++a)
#pragma unroll
            for (int b = 0; b < 2; ++b)
#pragma unroll
                for (int m = 0; m < 4; ++m)
#pragma unroll
                    for (int n = 0; n < 2; ++n) acc[a][b][m][n] = (f32x4){0.f, 0.f, 0.f, 0.f};
        cur = nxt; cA = nA; cB = nB; ++ui;
        if (wr == 1) PG8_BAR;
    }
    PG8_WAIT_V(0);
    PG8_BAR;
#undef PG8_SA
#undef PG8_SB
#undef PG8_STAGE
#undef PG8_LDA
#undef PG8_LDB
#undef PG8_MMA
#undef PG8_WAIT_V
#undef PG8_WAIT_L
#undef PG8_BAR
#undef PG8_SCHED
}
}

#define LDS_BAR() asm volatile("s_waitcnt lgkmcnt(0)\n\ts_barrier" ::: "memory")
enum { AT_MLA = 0, AT_SWA = 1, AT_NA = 2, AT_MEM = 3 };
struct AttnP {
    const bf16_t* Q; int ldq; int qoff;
    const bf16_t* K; const bf16_t* V;
    bf16_t* O; int ldo; int ooff;
    const float* qg; const float* kg;
    const float* sink; const float* relb;
    float* sso; int ssocol;
};
DI float max3f(float a, float b, float c) { float r; asm("v_max3_f32 %0, %1, %2, %3" : "=v"(r) : "v"(a), "v"(b), "v"(c)); return r; }
DI int crow(int r, int hi) { return (r & 3) + 8 * (r >> 2) + 4 * hi; }
DI s16x4 vtr(LAS const unsigned char* p) { typedef short v4i16_t __attribute__((ext_vector_type(4))); return __builtin_bit_cast(s16x4, __builtin_amdgcn_ds_read_tr16_b64_v4i16((LAS v4i16_t*)p)); }

template <int T>
DI void attn_unit(const AttnP& P, const int b, const int h, const int qb, LAS unsigned char* lds) {
    constexpr int DQK = (T == AT_MLA) ? 96 : 64, NS = DQK / 16, KS = DQK * 2 + 16, VS = 192, KBUF = 64 * KS, VBUF = 64 * VS, KCH = DQK / 8;
    constexpr int KOFF = 0, VOFF = 2 * 13312, BOFF = VOFF + 2 * VBUF;
    int tid = threadIdx.x; asm volatile("" : "+v"(tid));
    const int lane = tid & 63, wid = __builtin_amdgcn_readfirstlane(tid >> 6), r32 = lane & 31, hi = lane >> 5;
    const int q0 = qb * 256, qpos = q0 + 32 * wid + r32;
    const size_t qrow = (size_t)b * SEQ + qpos;
    int nt, kbase0; int na_r = 0, na_r0w = 0, na_kr0 = 0;
    if constexpr (T == AT_MLA) { nt = SEQ / 64; kbase0 = 0; }
    else if constexpr (T == AT_MEM) { nt = NMEM / 64; kbase0 = 0; }
    else if constexpr (T == AT_SWA) { nt = 8; kbase0 = q0 - 128; }
    else { const int R0 = qb * 4; na_kr0 = min(max(R0 - 4, 0), 120); const int krl = min(max(R0 + 3 - 4, 0), 120) + 7; nt = krl - na_kr0 + 1; kbase0 = 64 * na_kr0;
           na_r = R0 + (wid >> 1); na_r0w = min(max(na_r - 4, 0), 120); }
    if constexpr (T == AT_NA) { for (int i = tid; i < 465; i += 512) ((LAS float*)(lds + BOFF))[i] = P.relb[h * 465 + i] * LOG2E; }

    const int krow0 = tid / KCH, kpc0 = tid % KCH, krow1 = (tid + 512) / KCH, kpc1 = (tid + 512) % KCH, vrow = tid >> 3, vpc = tid & 7;
    float kgv[8];
    if constexpr (T != AT_MLA) {
#pragma unroll
        for (int j = 0; j < 8; ++j) kgv[j] = P.kg[kpc0 * 8 + j];
    }
    u32x4 kreg0 = {0, 0, 0, 0}, kreg1 = {0, 0, 0, 0}, vreg = {0, 0, 0, 0};
#define AT_LOAD(t) do { \
        if constexpr (T == AT_MLA) { \
            const bf16_t* kp = P.K + ((size_t)(b * 8 + h) * SEQ + (size_t)(t) * 64) * 96; \
            kreg0 = *(const u32x4*)(kp + tid * 8); if (tid < 256) kreg1 = *(const u32x4*)(kp + (tid + 512) * 8); \
            vreg = *(const u32x4*)(P.V + ((size_t)b * SEQ + (size_t)(t) * 64 + vrow) * 1024 + h * 128 + 64 + vpc * 8); \
        } else if constexpr (T == AT_MEM) { \
            kreg0 = *(const u32x4*)(P.K + ((size_t)b * NMEM + (t) * 64 + krow0) * 512 + h * 64 + kpc0 * 8); \
            vreg = *(const u32x4*)(P.V + ((size_t)b * NMEM + (t) * 64 + vrow) * 512 + 256 + h * 64 + vpc * 8); \
        } else { \
            const int kp_ = kbase0 + 64 * (t) + krow0; const bool ok_ = (kp_ >= 0) && (kp_ < SEQ); \
            const int hk_ = (T == AT_SWA) ? (h >> 1) : h; \
            const size_t ro_ = ((size_t)b * SEQ + (size_t)(ok_ ? kp_ : 0)) * ZW + hk_ * 64 + kpc0 * 8; \
            kreg0 = *(const u32x4*)(P.K + ro_); vreg = *(const u32x4*)(P.V + ro_); \
            if (!ok_) { kreg0 = (u32x4){0, 0, 0, 0}; vreg = (u32x4){0, 0, 0, 0}; } \
        } } while (0)
#define AT_STORE(bufi) do { \
        if constexpr (T != AT_MLA) { float f_[8]; unpack8(kreg0, f_); float ss_ = 0.f; \
            _Pragma("unroll") for (int j = 0; j < 8; ++j) ss_ += f_[j] * f_[j]; \
            ss_ += __shfl_xor(ss_, 1); ss_ += __shfl_xor(ss_, 2); ss_ += __shfl_xor(ss_, 4); \
            const float rs_ = rsqrtf(ss_ * (1.0f / 64.0f) + EPS); \
            _Pragma("unroll") for (int j = 0; j < 8; ++j) f_[j] *= rs_ * kgv[j]; \
            kreg0 = pack8(f_); } \
        *(LAS u32x4*)(lds + KOFF + (bufi) * KBUF + krow0 * KS + kpc0 * 16) = kreg0; \
        if constexpr (T == AT_MLA) { if (tid < 256) *(LAS u32x4*)(lds + KOFF + (bufi) * KBUF + krow1 * KS + kpc1 * 16) = kreg1; } \
        *(LAS u32x4*)(lds + VOFF + (bufi) * VBUF + vrow * VS + vpc * 16) = vreg; } while (0)

    AT_LOAD(0);
    bf16x8 qf[NS];
    {
        const bf16_t* qsrc = P.Q + qrow * P.ldq + P.qoff + h * DQK + 8 * hi;
        float qv[NS][8]; float ss = 0.f;
#pragma unroll
        for (int s = 0; s < NS; ++s) { const u32x4 w = *(const u32x4*)(qsrc + 16 * s); unpack8(w, qv[s]);
#pragma unroll
            for (int j = 0; j < 8; ++j) ss += qv[s][j] * qv[s][j]; }
        ss += __shfl_xor(ss, 32);
        const float rs = rsqrtf(ss * (1.0f / DQK) + EPS);
#pragma unroll
        for (int s = 0; s < NS; ++s) { const f32x4 g0 = *(const f32x4*)(P.qg + 16 * s + 8 * hi), g1 = *(const f32x4*)(P.qg + 16 * s + 8 * hi + 4);
#pragma unroll
            for (int j = 0; j < 4; ++j) { qv[s][j] *= rs * g0[j]; qv[s][4 + j] *= rs * g1[j]; } }
        if constexpr (T == AT_MLA) {
#pragma unroll
            for (int j = 0; j < 8; ++j) { float c, sn; rope_cs(qpos, 8 * hi + j, c, sn); const float x1 = qv[4][j], x2 = qv[5][j]; qv[4][j] = x1 * c - x2 * sn; qv[5][j] = x1 * sn + x2 * c; }
        }
        const float sc = ((T == AT_MLA) ? 0.10206207261596575f : 0.125f) * LOG2E;
#pragma unroll
        for (int s = 0; s < NS; ++s) {
#pragma unroll
            for (int j = 0; j < 8; ++j) qv[s][j] *= sc;
            qf[s] = __builtin_bit_cast(bf16x8, pack8(qv[s])); }
    }
    AT_STORE(0);
    LDS_BAR();

    f32x16 o0, o1;
#pragma unroll
    for (int r = 0; r < 16; ++r) { o0[r] = 0.f; o1[r] = 0.f; }
    float m_run = -1e30f, l_run = 0.f;
    const int q4 = (lane & 15) >> 2, p4 = lane & 3, blk = (lane >> 4) & 1;
    const int vfo = (4 * hi + q4) * VS + (16 * blk + 4 * p4) * 2;
    float slope2 = 0.f;
    if constexpr (T == AT_SWA) slope2 = exp2f(-2.0f * (float)(h + 1)) * LOG2E;
    const int qw0 = q0 + 32 * wid;
    const int na_c = qpos & 63, na_c0 = min(max(na_c - 8, 0), 48);

    for (int t = 0; t < nt; ++t) {
        const bool more = (t + 1 < nt);
        if (more) AT_LOAD(t + 1);
        const int kb0 = kbase0 + 64 * t;
        bool active = true;
        if constexpr (T == AT_SWA) active = (kb0 + 63 >= qw0 - 128) && (kb0 <= qw0 + 159) && (kb0 + 63 >= 0) && (kb0 < SEQ);
        if constexpr (T == AT_NA) { const int kr = na_kr0 + t; active = (kr >= na_r0w) && (kr <= na_r0w + 7); }
        if (active) {
            f32x16 p0, p1;
#pragma unroll
            for (int r = 0; r < 16; ++r) { p0[r] = 0.f; p1[r] = 0.f; }
            const LAS unsigned char* kb = lds + KOFF + (t & 1) * KBUF + r32 * KS + hi * 16;
#pragma unroll
            for (int s = 0; s < NS; ++s) {
                const bf16x8 k0 = *(const LAS bf16x8*)(kb + s * 32), k1 = *(const LAS bf16x8*)(kb + 32 * KS + s * 32);
                p0 = __builtin_amdgcn_mfma_f32_32x32x16_bf16(k0, qf[s], p0, 0, 0, 0);
                p1 = __builtin_amdgcn_mfma_f32_32x32x16_bf16(k1, qf[s], p1, 0, 0, 0);
            }
            if constexpr (T == AT_SWA) {
#pragma unroll
                for (int r = 0; r < 16; ++r) {
                    const int kp0 = kb0 + crow(r, hi), kp1 = kp0 + 32;
                    const int d0 = abs(qpos - kp0), d1 = abs(qpos - kp1);
                    p0[r] = (d0 <= 128 && kp0 >= 0 && kp0 < SEQ) ? p0[r] - slope2 * (float)d0 : -1e30f;
                    p1[r] = (d1 <= 128 && kp1 >= 0 && kp1 < SEQ) ? p1[r] - slope2 * (float)d1 : -1e30f;
                }
            }
            if constexpr (T == AT_NA) {
                const int dr = (na_kr0 + t) - na_r + 7;
                const LAS float* bt = (const LAS float*)(lds + BOFF) + dr * 31 + 15 - na_c;
#pragma unroll
                for (int r = 0; r < 16; ++r) {
                    const int kc0 = crow(r, hi), kc1 = kc0 + 32;
                    const bool ok0 = (kc0 >= na_c0) && (kc0 < na_c0 + 16), ok1 = (kc1 >= na_c0) && (kc1 < na_c0 + 16);
                    const float b0 = bt[ok0 ? kc0 : na_c], b1 = bt[ok1 ? kc1 : na_c];
                    p0[r] = ok0 ? p0[r] + b0 : -1e30f;
                    p1[r] = ok1 ? p1[r] + b1 : -1e30f;
                }
            }
            float mx = fmaxf(p0[0], p1[0]);
#pragma unroll
            for (int r = 1; r < 16; ++r) mx = fmaxf(mx, fmaxf(p0[r], p1[r]));
            mx = fmaxf(mx, __shfl_xor(mx, 32));
            const float mn = fmaxf(fmaxf(m_run, mx), -1e20f);
            const float alpha = __builtin_amdgcn_exp2f(m_run - mn);
            m_run = mn; l_run *= alpha;
            if (__any(alpha != 1.0f)) {
#pragma unroll
                for (int r = 0; r < 16; ++r) { o0[r] *= alpha; o1[r] *= alpha; }
            }
            float ps = 0.f;
#pragma unroll
            for (int r = 0; r < 16; ++r) { p0[r] = __builtin_amdgcn_exp2f(p0[r] - mn); p1[r] = __builtin_amdgcn_exp2f(p1[r] - mn); ps += p0[r] + p1[r]; }
            l_run += ps;
            bf16x8 pa[4];
            { u32x4 w;
              w.x = pk2(p0[0], p0[1]); w.y = pk2(p0[2], p0[3]); w.z = pk2(p0[4], p0[5]); w.w = pk2(p0[6], p0[7]); pa[0] = __builtin_bit_cast(bf16x8, w);
              w.x = pk2(p0[8], p0[9]); w.y = pk2(p0[10], p0[11]); w.z = pk2(p0[12], p0[13]); w.w = pk2(p0[14], p0[15]); pa[1] = __builtin_bit_cast(bf16x8, w);
              w.x = pk2(p1[0], p1[1]); w.y = pk2(p1[2], p1[3]); w.z = pk2(p1[4], p1[5]); w.w = pk2(p1[6], p1[7]); pa[2] = __builtin_bit_cast(bf16x8, w);
              w.x = pk2(p1[8], p1[9]); w.y = pk2(p1[10], p1[11]); w.z = pk2(p1[12], p1[13]); w.w = pk2(p1[14], p1[15]); pa[3] = __builtin_bit_cast(bf16x8, w); }
            const LAS unsigned char* vb = lds + VOFF + (t & 1) * VBUF + vfo;
#pragma unroll
            for (int s = 0; s < 4; ++s) {
                const s16x4 a0 = vtr(vb + (16 * s) * VS), a1 = vtr(vb + (16 * s + 8) * VS), c0 = vtr(vb + (16 * s) * VS + 64), c1 = vtr(vb + (16 * s + 8) * VS + 64);
                const bf16x8 v0 = __builtin_shufflevector(a0, a1, 0, 1, 2, 3, 4, 5, 6, 7), v1 = __builtin_shufflevector(c0, c1, 0, 1, 2, 3, 4, 5, 6, 7);
                o0 = __builtin_amdgcn_mfma_f32_32x32x16_bf16(v0, pa[s], o0, 0, 0, 0);
                o1 = __builtin_amdgcn_mfma_f32_32x32x16_bf16(v1, pa[s], o1, 0, 0, 0);
            }
        }
        if (more) AT_STORE((t + 1) & 1);
        LDS_BAR();
    }
#undef AT_LOAD
#undef AT_STORE
    float l_tot = l_run + __shfl_xor(l_run, 32);
    if constexpr (T == AT_SWA) l_tot += __builtin_amdgcn_exp2f(P.sink[h] * LOG2E - m_run);
    const float inv = 1.0f / l_tot;
    if (P.sso) { float ss_ = 0.f;
#pragma unroll
        for (int r = 0; r < 16; ++r) { const float a_ = o0[r] * inv, b_ = o1[r] * inv; ss_ += a_ * a_ + b_ * b_; }
        ss_ += __shfl_xor(ss_, 32);
        if (hi == 0) P.sso[qrow * 16 + P.ssocol + h] = ss_; }
    bf16_t* dst = P.O + qrow * P.ldo + P.ooff + h * 64 + 4 * hi;
#pragma unroll
    for (int g = 0; g < 4; ++g) {
        u32x2 w0, w1;
        w0.x = pk2(o0[4 * g] * inv, o0[4 * g + 1] * inv); w0.y = pk2(o0[4 * g + 2] * inv, o0[4 * g + 3] * inv);
        w1.x = pk2(o1[4 * g] * inv, o1[4 * g + 1] * inv); w1.y = pk2(o1[4 * g + 2] * inv, o1[4 * g + 3] * inv);
        *(u32x2*)(dst + 8 * g) = w0; *(u32x2*)(dst + 32 + 8 * g) = w1;
    }
}


DI void mla_unit(const AttnP& P, const int b, const int h, const int qb, LAS unsigned char* lds) {
    constexpr int DQK = 96, NS = 6, KS = 208, VS = 192, KBUF = 64 * KS, VBUF = 64 * VS, NT = SEQ / 64;
    constexpr int KOFF = 0, VOFF = 3 * KBUF;
    int tid = threadIdx.x; asm volatile("" : "+v"(tid));
    const int lane = tid & 63, wid = __builtin_amdgcn_readfirstlane(tid >> 6), r32 = lane & 31, hi = lane >> 5, grp = wid >> 2;
    const int q0 = qb * 256, qpos = q0 + 32 * wid + r32;
    const size_t qrow = (size_t)b * SEQ + qpos;
    const int krow0 = tid / 12, kpc0 = tid % 12, krow1 = (tid + 512) / 12, kpc1 = (tid + 512) % 12, vrow = tid >> 3, vpc = tid & 7;
    const bf16_t* kbase = P.K + ((size_t)(b * 8 + h) * SEQ) * 96 + tid * 8;
    const bf16_t* vbase = P.V + ((size_t)b * SEQ + vrow) * 1024 + h * 128 + 64 + vpc * 8;
    u32x4 kreg0, kreg1 = {0, 0, 0, 0}, vreg;
#define ML_LOAD(t) do { const bf16_t* kp_ = kbase + (size_t)(t) * (64 * 96); kreg0 = *(const u32x4*)kp_; if (tid < 256) kreg1 = *(const u32x4*)(kp_ + 512 * 8); \
        vreg = *(const u32x4*)(vbase + (size_t)(t) * (64 * 1024)); } while (0)
#define ML_STORE(bufi) do { *(LAS u32x4*)(lds + KOFF + (bufi) * KBUF + krow0 * KS + kpc0 * 16) = kreg0; \
        if (tid < 256) *(LAS u32x4*)(lds + KOFF + (bufi) * KBUF + krow1 * KS + kpc1 * 16) = kreg1; \
        *(LAS u32x4*)(lds + VOFF + (bufi) * VBUF + vrow * VS + vpc * 16) = vreg; } while (0)
    ML_LOAD(0);
    bf16x8 qf[NS];
    {
        const bf16_t* qsrc = P.Q + qrow * P.ldq + P.qoff + h * DQK + 8 * hi;
        float qv[NS][8]; float ss = 0.f;
#pragma unroll
        for (int s = 0; s < NS; ++s) { const u32x4 w = *(const u32x4*)(qsrc + 16 * s); unpack8(w, qv[s]);
#pragma unroll
            for (int j = 0; j < 8; ++j) ss += qv[s][j] * qv[s][j]; }
        ss += __shfl_xor(ss, 32);
        const float rs = rsqrtf(ss * (1.0f / DQK) + EPS);
#pragma unroll
        for (int s = 0; s < NS; ++s) { const f32x4 g0 = *(const f32x4*)(P.qg + 16 * s + 8 * hi), g1 = *(const f32x4*)(P.qg + 16 * s + 8 * hi + 4);
#pragma unroll
            for (int j = 0; j < 4; ++j) { qv[s][j] *= rs * g0[j]; qv[s][4 + j] *= rs * g1[j]; } }
#pragma unroll
        for (int j = 0; j < 8; ++j) { float c, sn; rope_cs(qpos, 8 * hi + j, c, sn); const float x1 = qv[4][j], x2 = qv[5][j]; qv[4][j] = x1 * c - x2 * sn; qv[5][j] = x1 * sn + x2 * c; }
        const float sc = 0.10206207261596575f * LOG2E;
#pragma unroll
        for (int s = 0; s < NS; ++s) {
#pragma unroll
            for (int j = 0; j < 8; ++j) qv[s][j] *= sc;
            qf[s] = __builtin_bit_cast(bf16x8, pack8(qv[s])); }
    }
    ML_STORE(0);
    ML_LOAD(1);
    LDS_BAR();

    f32x16 o0, o1, o2, p0, p1, negm;
#pragma unroll
    for (int r = 0; r < 16; ++r) { o0[r] = 0.f; o1[r] = 0.f; o2[r] = 0.f; p0[r] = 0.f; p1[r] = 0.f; negm[r] = 0.f; }
    const bf16x8 ones = {0x3F80, 0x3F80, 0x3F80, 0x3F80, 0x3F80, 0x3F80, 0x3F80, 0x3F80};
    bf16x8 pa0 = {0, 0, 0, 0, 0, 0, 0, 0}, pa1 = pa0, pa2 = pa0, pa3 = pa0;
    float m_run = 0.f;
    const int q4 = (lane & 15) >> 2, p4 = lane & 3, blk = (lane >> 4) & 1;
    const int vfo = (4 * hi + q4) * VS + (16 * blk + 4 * p4) * 2;
    const int kfo = r32 * KS + hi * 16;
    bf16x8 fa_[2], fb_[2];

#define ML_SB __builtin_amdgcn_sched_barrier(0)
#define ML_NOPS asm volatile("s_nop 15\n\ts_nop 7" : "+v"(p0), "+v"(p1))
#define ML_VLD(dst, s_) do { const s16x4 a0_ = vtr(vb_ + (16 * (s_)) * VS), a1_ = vtr(vb_ + (16 * (s_) + 8) * VS), c0_ = vtr(vb_ + (16 * (s_)) * VS + 64), c1_ = vtr(vb_ + (16 * (s_) + 8) * VS + 64); \
        dst[0] = __builtin_shufflevector(a0_, a1_, 0, 1, 2, 3, 4, 5, 6, 7); dst[1] = __builtin_shufflevector(c0_, c1_, 0, 1, 2, 3, 4, 5, 6, 7); } while (0)
#define ML_KLD(dst, s_) do { dst[0] = *(const LAS bf16x8*)(kb_ + (s_) * 32); dst[1] = *(const LAS bf16x8*)(kb_ + 32 * KS + (s_) * 32); } while (0)
#define ML_PVM(v, pp) do { o0 = __builtin_amdgcn_mfma_f32_32x32x16_bf16(v[0], pp, o0, 0, 0, 0); o1 = __builtin_amdgcn_mfma_f32_32x32x16_bf16(v[1], pp, o1, 0, 0, 0); } while (0)
#define ML_LSUM(pp) do { o2 = __builtin_amdgcn_mfma_f32_32x32x16_bf16(ones, pp, o2, 0, 0, 0); } while (0)
#define ML_QKM(k, s_, c0, c1) do { p0 = __builtin_amdgcn_mfma_f32_32x32x16_bf16(k[0], qf[s_], c0, 0, 0, 0); p1 = __builtin_amdgcn_mfma_f32_32x32x16_bf16(k[1], qf[s_], c1, 0, 0, 0); } while (0)
#define ML_PTRS(bk, bv) __builtin_amdgcn_s_setprio(2); const LAS unsigned char* vb_ = lds + VOFF + (bv) * VBUF + vfo; const LAS unsigned char* kb_ = lds + KOFF + (bk) * KBUF + kfo; bf16x8 fc_[2], fd_[2]
#define ML_MFMA_FULL(bk, bv) do { ML_PTRS(bk, bv); \
            ML_VLD(fc_, 2); ML_VLD(fd_, 3); ML_PVM(fa_, pa0); ML_LSUM(pa0); ML_PVM(fb_, pa1); ML_LSUM(pa1); ML_SB; \
            ML_KLD(fa_, 0); ML_KLD(fb_, 1); ML_PVM(fc_, pa2); ML_LSUM(pa2); ML_PVM(fd_, pa3); ML_LSUM(pa3); ML_SB; \
            ML_KLD(fc_, 2); ML_KLD(fd_, 3); ML_QKM(fa_, 0, negm, negm); ML_QKM(fb_, 1, p0, p1); ML_SB; \
            ML_KLD(fa_, 4); ML_KLD(fb_, 5); ML_QKM(fc_, 2, p0, p1); ML_QKM(fd_, 3, p0, p1); ML_SB; \
            ML_QKM(fa_, 4, p0, p1); ML_QKM(fb_, 5, p0, p1); ML_NOPS; ML_SB; __builtin_amdgcn_s_setprio(0); } while (0)
#define ML_MFMA_FIRST(bk) do { ML_PTRS(bk, 0); (void)vb_; \
            ML_KLD(fa_, 0); ML_KLD(fb_, 1); ML_SB; \
            ML_KLD(fc_, 2); ML_KLD(fd_, 3); ML_QKM(fa_, 0, negm, negm); ML_QKM(fb_, 1, p0, p1); ML_SB; \
            ML_KLD(fa_, 4); ML_KLD(fb_, 5); ML_QKM(fc_, 2, p0, p1); ML_QKM(fd_, 3, p0, p1); ML_SB; \
            ML_QKM(fa_, 4, p0, p1); ML_QKM(fb_, 5, p0, p1); ML_NOPS; ML_SB; __builtin_amdgcn_s_setprio(0); } while (0)
#define ML_MFMA_LAST(bv) do { ML_PTRS(0, bv); (void)kb_; \
            ML_VLD(fc_, 2); ML_VLD(fd_, 3); ML_PVM(fa_, pa0); ML_LSUM(pa0); ML_PVM(fb_, pa1); ML_LSUM(pa1); ML_SB; \
            ML_PVM(fc_, pa2); ML_LSUM(pa2); ML_PVM(fd_, pa3); ML_LSUM(pa3); ML_SB; __builtin_amdgcn_s_setprio(0); } while (0)
#define ML_SOFTMAX(first_, bvn_) do { \
        float ma_ = max3f(p0[0], p0[1], p1[0]), mb_ = max3f(p0[2], p0[3], p1[1]); ma_ = max3f(ma_, p1[2], p1[3]); \
        _Pragma("unroll") for (int r = 4; r < 16; r += 4) { ma_ = max3f(ma_, p0[r], p0[r + 1]); mb_ = max3f(mb_, p0[r + 2], p0[r + 3]); ma_ = max3f(ma_, p1[r], p1[r + 1]); mb_ = max3f(mb_, p1[r + 2], p1[r + 3]); } \
        float mx_ = max3f(ma_, mb_, mb_); \
        mx_ = max3f(mx_, __shfl_xor(mx_, 32), mx_); \
        if (first_ || __any(mx_ > 8.0f)) { const float dl_ = first_ ? mx_ : max3f(mx_, 0.0f, 0.0f); m_run += dl_; \
            _Pragma("unroll") for (int r = 0; r < 16; ++r) { p0[r] -= dl_; p1[r] -= dl_; negm[r] = -m_run; } \
            if (!first_) { const float f_ = __builtin_amdgcn_exp2f(-dl_); \
                _Pragma("unroll") for (int r = 0; r < 16; ++r) { o0[r] *= f_; o1[r] *= f_; o2[r] *= f_; } } } \
        _Pragma("unroll") for (int r = 0; r < 16; ++r) { p0[r] = __builtin_amdgcn_exp2f(p0[r]); p1[r] = __builtin_amdgcn_exp2f(p1[r]); } \
        { u32x4 w_; \
          w_.x = pk2(p0[0], p0[1]); w_.y = pk2(p0[2], p0[3]); w_.z = pk2(p0[4], p0[5]); w_.w = pk2(p0[6], p0[7]); pa0 = __builtin_bit_cast(bf16x8, w_); \
          w_.x = pk2(p0[8], p0[9]); w_.y = pk2(p0[10], p0[11]); w_.z = pk2(p0[12], p0[13]); w_.w = pk2(p0[14], p0[15]); pa1 = __builtin_bit_cast(bf16x8, w_); \
          w_.x = pk2(p1[0], p1[1]); w_.y = pk2(p1[2], p1[3]); w_.z = pk2(p1[4], p1[5]); w_.w = pk2(p1[6], p1[7]); pa2 = __builtin_bit_cast(bf16x8, w_); \
          w_.x = pk2(p1[8], p1[9]); w_.y = pk2(p1[10], p1[11]); w_.z = pk2(p1[12], p1[13]); w_.w = pk2(p1[14], p1[15]); pa3 = __builtin_bit_cast(bf16x8, w_); } \
        { const LAS unsigned char* vb_ = lds + VOFF + (bvn_) * VBUF + vfo; ML_VLD(fa_, 0); ML_VLD(fb_, 1); } } while (0)

#define ML_LDST(i) do { ML_STORE(bl); { const int tn_ = ((i) + 2 < NT) ? (i) + 2 : NT - 1; ML_LOAD(tn_); } } while (0)
#define ML_ROT() do { bv = bk; bk = bl; bl = (bl == 2) ? 0 : bl + 1; } while (0)
    int bk = 0, bv = 2, bl = 1;
    if (grp == 0) {
        ML_MFMA_FIRST(bk); ML_LDST(0); LDS_BAR();
        ML_SOFTMAX(true, bk); LDS_BAR(); ML_ROT();
        for (int i = 1; i < NT; ++i) {
            ML_MFMA_FULL(bk, bv); ML_LDST(i); LDS_BAR();
            ML_SOFTMAX(false, bk); LDS_BAR(); ML_ROT();
        }
        ML_MFMA_LAST(bv); LDS_BAR();
        LDS_BAR();
    } else {
        ML_LDST(0); LDS_BAR();
        ML_MFMA_FIRST(bk); LDS_BAR(); ML_ROT();
        ML_SOFTMAX(true, bv); ML_LDST(1); LDS_BAR();
        ML_MFMA_FULL(bk, bv); LDS_BAR(); ML_ROT();
        for (int i = 2; i < NT; ++i) {
            ML_SOFTMAX(false, bv); ML_LDST(i); LDS_BAR();
            ML_MFMA_FULL(bk, bv); LDS_BAR(); ML_ROT();
        }
        ML_SOFTMAX(false, bv); LDS_BAR();
        ML_MFMA_LAST(bv); LDS_BAR();
    }
#undef ML_LDST
#undef ML_ROT
#undef ML_PTRS
#undef ML_MFMA_FULL
#undef ML_MFMA_FIRST
#undef ML_MFMA_LAST
#undef ML_LOAD
#undef ML_STORE
#undef ML_SB
#undef ML_NOPS
#undef ML_LSUM
#undef ML_VLD
#undef ML_KLD
#undef ML_PVM
#undef ML_QKM
#undef ML_SOFTMAX
    const float inv = 1.0f / o2[0];
    if (P.sso) { float ss_ = 0.f;
#pragma unroll
        for (int r = 0; r < 16; ++r) { const float a_ = o0[r] * inv, b_ = o1[r] * inv; ss_ += a_ * a_ + b_ * b_; }
        ss_ += __shfl_xor(ss_, 32);
        if (hi == 0) P.sso[qrow * 16 + P.ssocol + h] = ss_; }
    bf16_t* dst = P.O + qrow * P.ldo + P.ooff + h * 64 + 4 * hi;
#pragma unroll
    for (int g = 0; g < 4; ++g) {
        u32x2 w0, w1;
        w0.x = pk2(o0[4 * g] * inv, o0[4 * g + 1] * inv); w0.y = pk2(o0[4 * g + 2] * inv, o0[4 * g + 3] * inv);
        w1.x = pk2(o1[4 * g] * inv, o1[4 * g + 1] * inv); w1.y = pk2(o1[4 * g + 2] * inv, o1[4 * g + 3] * inv);
        *(u32x2*)(dst + 8 * g) = w0; *(u32x2*)(dst + 32 + 8 * g) = w1;
    }
}


DI void glds16(const void* gsrc, unsigned lds_dst) { unsigned keep;
    asm volatile("s_mov_b32 %0, m0\n\ts_mov_b32 m0, %2\n\ts_nop 0\n\tglobal_load_lds_dwordx4 %1, off\n\ts_mov_b32 m0, %0" : "=&s"(keep) : "v"(gsrc), "s"(lds_dst) : "memory"); }
DI void mla_unit_fast(const AttnP& P, const int b, const int h, const int qb, LAS unsigned char* lds) {
    constexpr int DQK = 96, NS = 6, KS = 208, VS = 192, KBUF = 64 * KS, VBUF = 64 * VS, SLOT = KBUF + VBUF, NT = SEQ / 64;
    int tid = threadIdx.x; asm volatile("" : "+v"(tid));
    const int lane = tid & 63, wid = __builtin_amdgcn_readfirstlane(tid >> 6), r32 = lane & 31, hi = lane >> 5, grp = wid >> 2;
    const int q0 = qb * 256, qpos = q0 + 32 * wid + r32;
    const size_t qrow = (size_t)b * SEQ + qpos;
    const char* kbase = (const char*)(P.K + ((size_t)(b * 8 + h) * SEQ) * 96);
    const char* vbase = (const char*)(P.V + ((size_t)b * SEQ) * 1024 + h * 128 + 64);
    unsigned goff0, goff1, goff2, goff3 = 0; unsigned l0, l1, l2, l3 = 0; bool v1;
    { int sg = 64 * wid + lane; int r = sg / 13, c = sg % 13; goff0 = (unsigned)(r * 192 + (c < 12 ? c : 11) * 16); l0 = (unsigned)(wid * 1024); }
    if (wid <= 4) { int sg = 64 * (wid + 8) + lane; int r = sg / 13, c = sg % 13; goff1 = (unsigned)(r * 192 + (c < 12 ? c : 11) * 16); l1 = (unsigned)((wid + 8) * 1024); v1 = false; }
    else          { int sg = 64 * (wid - 5) + lane; int r = sg / 12, c = sg % 12; goff1 = (unsigned)(r * 2048 + (c < 8 ? c : 7) * 16); l1 = (unsigned)(KBUF + (wid - 5) * 1024); v1 = true; }
    { int sg = 64 * (wid + 3) + lane; int r = sg / 12, c = sg % 12; goff2 = (unsigned)(r * 2048 + (c < 8 ? c : 7) * 16); l2 = (unsigned)(KBUF + (wid + 3) * 1024); }
    if (wid == 0) { int sg = 64 * 11 + lane; int r = sg / 12, c = sg % 12; goff3 = (unsigned)(r * 2048 + (c < 8 ? c : 7) * 16); l3 = (unsigned)(KBUF + 11 * 1024); }
    const unsigned ldsb = (unsigned)(size_t)lds;
#define MF_DMA(t, rs) do { const char* kt_ = kbase + (size_t)(t) * 12288; const char* vt_ = vbase + (size_t)(t) * 131072; const unsigned sb_ = ldsb + (unsigned)(rs) * SLOT; \
        glds16(kt_ + goff0, (unsigned)__builtin_amdgcn_readfirstlane((int)(sb_ + l0))); \
        glds16((v1 ? vt_ : kt_) + goff1, (unsigned)__builtin_amdgcn_readfirstlane((int)(sb_ + l1))); \
        glds16(vt_ + goff2, (unsigned)__builtin_amdgcn_readfirstlane((int)(sb_ + l2))); \
        if (wid == 0) glds16(vt_ + goff3, (unsigned)__builtin_amdgcn_readfirstlane((int)(sb_ + l3))); } while (0)
    MF_DMA(0, 0); MF_DMA(1, 1); MF_DMA(2, 2);
    bf16x8 qf[NS];
    {
        const bf16_t* qsrc = P.Q + qrow * P.ldq + P.qoff + h * DQK + 8 * hi;
        float qv[NS][8]; float ss = 0.f;
#pragma unroll
        for (int s = 0; s < NS; ++s) { const u32x4 w = *(const u32x4*)(qsrc + 16 * s); unpack8(w, qv[s]);
#pragma unroll
            for (int j = 0; j < 8; ++j) ss += qv[s][j] * qv[s][j]; }
        ss += __shfl_xor(ss, 32);
        const float rs = rsqrtf(ss * (1.0f / DQK) + EPS);
#pragma unroll
        for (int s = 0; s < NS; ++s) { const f32x4 g0 = *(const f32x4*)(P.qg + 16 * s + 8 * hi), g1 = *(const f32x4*)(P.qg + 16 * s + 8 * hi + 4);
#pragma unroll
            for (int j = 0; j < 4; ++j) { qv[s][j] *= rs * g0[j]; qv[s][4 + j] *= rs * g1[j]; } }
#pragma unroll
        for (int j = 0; j < 8; ++j) { float c, sn; rope_cs(qpos, 8 * hi + j, c, sn); const float x1 = qv[4][j], x2 = qv[5][j]; qv[4][j] = x1 * c - x2 * sn; qv[5][j] = x1 * sn + x2 * c; }
        const float sc = 0.10206207261596575f * LOG2E;
#pragma unroll
        for (int s = 0; s < NS; ++s) {
#pragma unroll
            for (int j = 0; j < 8; ++j) qv[s][j] *= sc;
            qf[s] = __builtin_bit_cast(bf16x8, pack8(qv[s])); }
    }
    asm volatile("s_waitcnt vmcnt(0)" ::: "memory");
    LDS_BAR();

    f32x16 o0, o1, pA0, pA1, pB0, pB1, z16;
#pragma unroll
    for (int r = 0; r < 16; ++r) { o0[r] = 0.f; o1[r] = 0.f; pA0[r] = 0.f; pA1[r] = 0.f; pB0[r] = 0.f; pB1[r] = 0.f; z16[r] = 0.f; }
    bf16x8 pa0, pa1, pa2, pa3;
    float l_run = 0.f;
    const int q4 = (lane & 15) >> 2, p4 = lane & 3, blk = (lane >> 4) & 1;
    const int vfo = KBUF + (4 * hi + q4) * VS + (16 * blk + 4 * p4) * 2;
    const int kfo = r32 * KS + hi * 16;
#define MF_SB __builtin_amdgcn_sched_barrier(0)
#define MF_VLD(dst, s_) do { const s16x4 a0_ = vtr(vb_ + (16 * (s_)) * VS), a1_ = vtr(vb_ + (16 * (s_) + 8) * VS), c0_ = vtr(vb_ + (16 * (s_)) * VS + 64), c1_ = vtr(vb_ + (16 * (s_) + 8) * VS + 64); \
        dst[0] = __builtin_shufflevector(a0_, a1_, 0, 1, 2, 3, 4, 5, 6, 7); dst[1] = __builtin_shufflevector(c0_, c1_, 0, 1, 2, 3, 4, 5, 6, 7); } while (0)
#define MF_KLD(dst, s_) do { dst[0] = *(const LAS bf16x8*)(kb_ + (s_) * 32); dst[1] = *(const LAS bf16x8*)(kb_ + 32 * KS + (s_) * 32); } while (0)
#define MF_PVM(v, pp) do { o0 = __builtin_amdgcn_mfma_f32_32x32x16_bf16(v[0], pp, o0, 0, 0, 0); o1 = __builtin_amdgcn_mfma_f32_32x32x16_bf16(v[1], pp, o1, 0, 0, 0); } while (0)
#define MF_QKM(PO0, PO1, k, s_, c0, c1) do { PO0 = __builtin_amdgcn_mfma_f32_32x32x16_bf16(k[0], qf[s_], c0, 0, 0, 0); PO1 = __builtin_amdgcn_mfma_f32_32x32x16_bf16(k[1], qf[s_], c1, 0, 0, 0); } while (0)
#define MF_SMX(PX, B8, PAK) do { float e_[8]; float ps_ = 0.f; \
        _Pragma("unroll") for (int j = 0; j < 8; ++j) { e_[j] = __builtin_amdgcn_exp2f(PX[(B8) + j]); ps_ += e_[j]; } \
        l_run += ps_; PAK = __builtin_bit_cast(bf16x8, pack8(e_)); } while (0)
#define MF_LAND(t) do { if ((t) + 3 < NT) asm volatile("s_waitcnt vmcnt(3)" ::: "memory"); else asm volatile("s_waitcnt vmcnt(0)" ::: "memory"); } while (0)
#define MF_ITER(t, PI0, PI1, PO0, PO1) do { \
        const LAS unsigned char* kb_ = lds + (((t) + 1) & 3) * SLOT + kfo; const LAS unsigned char* vb_ = lds + ((t) & 3) * SLOT + vfo; \
        bf16x8 fa_[2], fb_[2], fc_[2], fd_[2]; \
        MF_KLD(fa_, 0); MF_KLD(fb_, 1); MF_SB; \
        if ((t) + 3 < NT) MF_DMA((t) + 3, ((t) + 3) & 3);         \
        __builtin_amdgcn_s_setprio(1); \
        MF_KLD(fc_, 2); MF_KLD(fd_, 3); MF_QKM(PO0, PO1, fa_, 0, z16, z16); MF_QKM(PO0, PO1, fb_, 1, PO0, PO1); MF_SMX(PI0, 0, pa0); MF_SB; \
        MF_KLD(fa_, 4); MF_KLD(fb_, 5); MF_QKM(PO0, PO1, fc_, 2, PO0, PO1); MF_QKM(PO0, PO1, fd_, 3, PO0, PO1); MF_SMX(PI0, 8, pa1); MF_SB; \
        MF_VLD(fc_, 0); MF_VLD(fd_, 1); MF_QKM(PO0, PO1, fa_, 4, PO0, PO1); MF_QKM(PO0, PO1, fb_, 5, PO0, PO1); MF_SMX(PI1, 0, pa2); MF_SB; \
        MF_VLD(fa_, 2); MF_VLD(fb_, 3); MF_SMX(PI1, 8, pa3); MF_PVM(fc_, pa0); MF_PVM(fd_, pa1); MF_SB; \
        MF_PVM(fa_, pa2); MF_PVM(fb_, pa3); MF_SB; \
        __builtin_amdgcn_s_setprio(0); \
        MF_LAND(t); LDS_BAR(); } while (0)
    {
        const LAS unsigned char* kb_ = lds + kfo; bf16x8 fa_[2], fb_[2], fc_[2], fd_[2];
        MF_KLD(fa_, 0); MF_KLD(fb_, 1); MF_KLD(fc_, 2); MF_KLD(fd_, 3);
        MF_QKM(pA0, pA1, fa_, 0, z16, z16); MF_QKM(pA0, pA1, fb_, 1, pA0, pA1); MF_KLD(fa_, 4); MF_KLD(fb_, 5);
        MF_QKM(pA0, pA1, fc_, 2, pA0, pA1); MF_QKM(pA0, pA1, fd_, 3, pA0, pA1); MF_QKM(pA0, pA1, fa_, 4, pA0, pA1); MF_QKM(pA0, pA1, fb_, 5, pA0, pA1);
    }
    for (int t = 0; t < NT - 2; t += 2) {
        MF_ITER(t, pA0, pA1, pB0, pB1);
        MF_ITER(t + 1, pB0, pB1, pA0, pA1);
    }
    MF_ITER(NT - 2, pA0, pA1, pB0, pB1);
    {
        const LAS unsigned char* vb_ = lds + ((NT - 1) & 3) * SLOT + vfo; bf16x8 fa_[2], fb_[2], fc_[2], fd_[2];
        MF_VLD(fc_, 0); MF_VLD(fd_, 1); MF_VLD(fa_, 2); MF_VLD(fb_, 3);
        MF_SMX(pB0, 0, pa0); MF_SMX(pB0, 8, pa1); MF_SMX(pB1, 0, pa2); MF_SMX(pB1, 8, pa3);
        MF_PVM(fc_, pa0); MF_PVM(fd_, pa1); MF_PVM(fa_, pa2); MF_PVM(fb_, pa3);
        LDS_BAR();
    }
#undef MF_DMA
#undef MF_SB
#undef MF_VLD
#undef MF_KLD
#undef MF_PVM
#undef MF_QKM
#undef MF_SMX
#undef MF_LAND
#undef MF_ITER
    const float inv = 1.0f / (l_run + __shfl_xor(l_run, 32));
    if (P.sso) { float ss_ = 0.f;
#pragma unroll
        for (int r = 0; r < 16; ++r) { const float a_ = o0[r] * inv, b_ = o1[r] * inv; ss_ += a_ * a_ + b_ * b_; }
        ss_ += __shfl_xor(ss_, 32);
        if (hi == 0) P.sso[qrow * 16 + P.ssocol + h] = ss_; }
    bf16_t* dst = P.O + qrow * P.ldo + P.ooff + h * 64 + 4 * hi;
#pragma unroll
    for (int g = 0; g < 4; ++g) {
        u32x2 w0, w1;
        w0.x = pk2(o0[4 * g] * inv, o0[4 * g + 1] * inv); w0.y = pk2(o0[4 * g + 2] * inv, o0[4 * g + 3] * inv);
        w1.x = pk2(o1[4 * g] * inv, o1[4 * g + 1] * inv); w1.y = pk2(o1[4 * g + 2] * inv, o1[4 * g + 3] * inv);
        *(u32x2*)(dst + 8 * g) = w0; *(u32x2*)(dst + 32 + 8 * g) = w1;
    }
}

DI void wprep_item(const float* W, int K, int N, const float* gain, bf16_t* WT, int mapmode, LAS float* scr, int item, int lane) {
    const int nblk = N / 32, kb = item / nblk, nb = item % nblk, k0 = 64 * kb, n0 = 32 * nb;
    int row0 = n0;
    if (mapmode == 1) { const int j = (n0 < DFF) ? n0 : n0 - DFF; row0 = 256 * (j / 128) + (j % 128) + ((n0 < DFF) ? 0 : 128); }
    if (mapmode == 2) row0 = (n0 < 416) ? n0 : n0 + 96;
    const int r8 = lane >> 3, c4 = (lane & 7) * 4;
    f32x4 wv[8];
#pragma unroll
    for (int i = 0; i < 8; ++i) wv[i] = *(const f32x4*)(W + (size_t)(k0 + 8 * i + r8) * N + n0 + c4);
#pragma unroll
    for (int i = 0; i < 8; ++i) { const int kk = 8 * i + r8; const float gk = gain ? gain[k0 + kk] : 1.0f;
        scr[kk * 33 + c4] = wv[i].x * gk; scr[kk * 33 + c4 + 1] = wv[i].y * gk; scr[kk * 33 + c4 + 2] = wv[i].z * gk; scr[kk * 33 + c4 + 3] = wv[i].w * gk; }
    asm volatile("s_waitcnt lgkmcnt(0)" ::: "memory");
    const int c = lane & 7;
#pragma unroll
    for (int j = 0; j < 4; ++j) { const int n = (lane >> 3) + 8 * j; const LAS float* s = scr + (8 * c) * 33 + n;
        u32x4 o; o.x = pk2(s[0 * 33], s[1 * 33]); o.y = pk2(s[2 * 33], s[3 * 33]); o.z = pk2(s[4 * 33], s[5 * 33]); o.w = pk2(s[6 * 33], s[7 * 33]);
        *(u32x4*)(WT + (size_t)(row0 + n) * K + k0 + 8 * c) = o; }
    asm volatile("s_waitcnt lgkmcnt(0)" ::: "memory");
}


#define XB_TMO      128
#define XB_XCNT(j)  (256  + 64 * (j))
#define XB_XSUB(j)  (1280 + 64 * (j))
#define XB_XGEN(j)  (2304 + 64 * (j))
#define XB_TOP      3328
#define XB_TOPGEN   3392
#define XCD_BAR_WORDS 3456
#define XB_SPIN_CAP (1u << 22)
DI unsigned xb_ld(unsigned* p)              { return __hip_atomic_load(p, __ATOMIC_RELAXED, __HIP_MEMORY_SCOPE_AGENT); }
DI unsigned xb_add(unsigned* p, unsigned v) { return __hip_atomic_fetch_add(p, v, __ATOMIC_RELAXED, __HIP_MEMORY_SCOPE_AGENT); }
DI unsigned xb_xcc_id() { return (unsigned)__builtin_amdgcn_s_getreg((3 << 11) | 20) & 0xFu; }
#define XB_SPIN(cond, bar) do { unsigned _sp = 0; while (cond) { __builtin_amdgcn_s_sleep(1); \
    if ((++_sp & 255u) == 0u) { if (xb_ld(&(bar)[XB_TMO])) break; if (_sp > XB_SPIN_CAP) { atomicAdd(&(bar)[XB_TMO], 1u); break; } } } } while (0)
struct XcdBarrier { unsigned* bar; unsigned x; volatile LAS unsigned* st; };
DI XcdBarrier xcd_barrier_post(unsigned* bar, volatile LAS unsigned* st) {
    XcdBarrier b; b.bar = bar; b.x = xb_xcc_id(); b.st = st;
    if (threadIdx.x == 0) (void)xb_add(&bar[XB_XCNT(b.x)], 1u);
    return b;
}
DI void xcd_barrier_complete(unsigned* bar, unsigned x, unsigned& nloc, unsigned& nx) {
    const unsigned G = gridDim.x * gridDim.y * gridDim.z;
    unsigned sum, cnt, mine, sp = 0u;
    for (;;) {
        sum = 0u; cnt = 0u; mine = 0u;
#pragma unroll
        for (unsigned j = 0; j < 16; ++j) { const unsigned c = xb_ld(&bar[XB_XCNT(j)]); sum += c; cnt += (c > 0u) ? 1u : 0u; mine = (j == x) ? c : mine; }
        if (sum == G) break;
        __builtin_amdgcn_s_sleep(1);
        if ((++sp & 255u) == 0u) { if (xb_ld(&bar[XB_TMO])) break; if (sp > XB_SPIN_CAP) { atomicAdd(&bar[XB_TMO], 1u); break; } }
    }
    nloc = mine > 0u ? mine : 1u; nx = cnt > 0u ? cnt : 1u;
}
DI void xcd_barrier(const XcdBarrier& b) {
    asm volatile("s_waitcnt vmcnt(0) lgkmcnt(0)" ::: "memory");
    __syncthreads();
    if (threadIdx.x == 0) {
        unsigned* bar = b.bar;
        __builtin_amdgcn_s_waitcnt(0);
        unsigned nloc = b.st[0], nx = b.st[1];
        if (nloc == 0u) { xcd_barrier_complete(bar, b.x, nloc, nx); b.st[0] = nloc; b.st[1] = nx; }
        const unsigned old = xb_add(&bar[XB_XSUB(b.x)], 1u);
        const unsigned gen = old / nloc;
        if (old + 1u == (gen + 1u) * nloc) {
            __builtin_amdgcn_fence(__ATOMIC_RELEASE, "agent");
            asm volatile("s_waitcnt vmcnt(0)" ::: "memory");
            const unsigned og = xb_add(&bar[XB_TOP], 1u);
            const unsigned tg = og / nx;
            if (og + 1u == (tg + 1u) * nx) xb_add(&bar[XB_TOPGEN], 1u);
            else XB_SPIN(xb_ld(&bar[XB_TOPGEN]) == tg, bar);
            __builtin_amdgcn_fence(__ATOMIC_ACQUIRE, "agent");
            xb_add(&bar[XB_XGEN(b.x)], 1u);
            asm volatile("s_waitcnt vmcnt(0)" ::: "memory");
        } else {
            XB_SPIN(xb_ld(&bar[XB_XGEN(b.x)]) == gen, bar);
            __builtin_amdgcn_fence(__ATOMIC_ACQUIRE, "agent");
            asm volatile("s_waitcnt vmcnt(0)" ::: "memory");
        }
    }
    __syncthreads();
}

struct Args { const float* in[32]; float* out; unsigned char* ws; int ph_lo, ph_hi; };
typedef __attribute__((address_space(4))) const Args ArgsK;
struct ArgsV { const ArgsK* p; struct InV { const ArgsK* p; DI const float* operator[](int i) const { return p->in[i]; } } in; };
constexpr int PH_PER_LAYER = 14, N_PHASES = 1 + PH_PER_LAYER * NLAYER;

__global__ void __launch_bounds__(512, 2) mk_fwd(Args a_) {
    extern __shared__ __attribute__((aligned(16))) unsigned char lds_raw[];
    LAS unsigned char* lds = (LAS unsigned char*)lds_raw;
    const int ph_lo = a_.ph_lo, ph_hi = a_.ph_hi;
#if !MK_PER_PHASE
    if (ph_hi < 0) cg::this_grid().sync();
    volatile LAS unsigned* bst = (volatile LAS unsigned*)(lds + 131072 + 64);
    if (threadIdx.x == 0) { bst[0] = 0u; bst[1] = 0u; }
    __syncthreads();
    const XcdBarrier gbar = xcd_barrier_post((unsigned*)(a_.ws + WS_CTL), bst);
#endif

    for (int ph = ph_lo; ph < ph_hi; ++ph) {
        const ArgsK* ap = (const ArgsK*)__builtin_amdgcn_kernarg_segment_ptr();
        int tid = threadIdx.x; asm volatile("" : "+v"(tid));
        int G = gridDim.x, bx = blockIdx.x; asm volatile("" : "+s"(G), "+s"(bx));
        const int lane = tid & 63, wid = __builtin_amdgcn_readfirstlane(tid >> 6);
        const int vcu = (G % 8 == 0) ? (bx % 8) * (G / 8) + bx / 8 : bx;
        const int gw = vcu * 8 + wid, NGW = G * 8;
        asm volatile("" : "+s"(ap));
        const ArgsV a = {ap, {ap}};
        unsigned char* ws = ap->ws;
        bf16_t* WB = (bf16_t*)(ws + WS_W);
        bf16_t* XB = (bf16_t*)(ws + WS_XB); float* SS = (float*)(ws + WS_SS); float* SSZ = (float*)(ws + WS_SSZ);
        bf16_t* MEMN = (bf16_t*)(ws + WS_MEMN); bf16_t* MKV = (bf16_t*)(ws + WS_MKV);
        bf16_t* H = (bf16_t*)(ws + WS_H); bf16_t* Z = (bf16_t*)(ws + WS_Z); bf16_t* QR = (bf16_t*)(ws + WS_QR);
        bf16_t* KVR = (bf16_t*)(ws + WS_KVR); bf16_t* OB = (bf16_t*)(ws + WS_O); bf16_t* KF = (bf16_t*)(ws + WS_KF);
        bf16_t* QM = (bf16_t*)(ws + WS_QM); bf16_t* OM = (bf16_t*)(ws + WS_OM);
        float* XR = ap->out;
        if (ph == 0) { if (!(PHMASK & 1)) continue;
            LAS float* scr = (LAS float*)(lds + wid * 16384);
            constexpr int I0 = 2816, I1 = 1408, I2 = 848, I3 = 96, I4 = 64, I5 = 512, I6 = 128, I7 = 256, I8 = 128, IL = I0 + I1 + I2 + I3 + I4 + I5 + I6 + I7 + I8 + I0 + I1;
            for (int it = gw; it < IL * NLAYER; it += NGW) {
                const int l = it / IL; int r = it % IL; bf16_t* wl = WB + (size_t)l * W_LAYER;
                if (r < I0) { wprep_item(a.in[3] + (size_t)l * 1024 * 5632, 1024, 5632, a.in[2] + l * 1024, wl + WO_F1IN, 1, scr, r, lane); continue; } r -= I0;
                if (r < I1) { wprep_item(a.in[4] + (size_t)l * 2816 * 1024, 2816, 1024, nullptr, wl + WO_F1OUT, 0, scr, r, lane); continue; } r -= I1;
                if (r < I2) { wprep_item(a.in[6] + (size_t)l * 1024 * 1696, 1024, 1696, a.in[5] + l * 1024, wl + WO_MIX, 2, scr, r, lane); continue; } r -= I2;
                if (r < I3) { wprep_item(a.in[8] + (size_t)l * 256 * 768, 256, 768, a.in[7] + l * 256, wl + WO_UQ, 0, scr, r, lane); continue; } r -= I3;
                if (r < I4) { wprep_item(a.in[10] + (size_t)l * 128 * 1024, 128, 1024, a.in[9] + l * 128, wl + WO_UKV, 0, scr, r, lane); continue; } r -= I4;
                if (r < I5) { wprep_item(a.in[20] + (size_t)l * 1024 * 1024, 1024, 1024, a.in[19] + l * 1024, wl + WO_MO, 0, scr, r, lane); continue; } r -= I5;
                if (r < I6) { wprep_item(a.in[23] + (size_t)l * 1024 * 256, 1024, 256, a.in[21] + l * 1024, wl + WO_MQ, 0, scr, r, lane); continue; } r -= I6;
                if (r < I7) { wprep_item(a.in[24] + (size_t)l * 1024 * 512, 1024, 512, a.in[22] + l * 1024, wl + WO_MKV, 0, scr, r, lane); continue; } r -= I7;
                if (r < I8) { wprep_item(a.in[27] + (size_t)l * 256 * 1024, 256, 1024, nullptr, wl + WO_MOUT, 0, scr, r, lane); continue; } r -= I8;
                if (r < I0) { wprep_item(a.in[29] + (size_t)l * 1024 * 5632, 1024, 5632, a.in[28] + l * 1024, wl + WO_F2IN, 1, scr, r, lane); continue; } r -= I0;
                wprep_item(a.in[30] + (size_t)l * 2816 * 1024, 2816, 1024, nullptr, wl + WO_F2OUT, 0, scr, r, lane);
            }
            for (int i = bx * 512 + tid; i < NLAYER * 96 * 1024 / 8; i += G * 512) { const int l = i / (96 * 128), r = i % (96 * 128);
                *(u32x4*)(WB + (size_t)l * W_LAYER + WO_MIX + (size_t)416 * 1024 + (size_t)r * 8) = (u32x4){0, 0, 0, 0}; }
            const float* x0 = a.in[0];
            for (int m = gw; m < M; m += 2 * NGW) {
                const int m2 = (m + NGW < M) ? m + NGW : m;
                const f32x4* xr = (const f32x4*)(x0 + (size_t)m * DM) + lane; const f32x4* xr2 = (const f32x4*)(x0 + (size_t)m2 * DM) + lane;
                f32x4 va[4], vb[4];
#pragma unroll
                for (int j = 0; j < 4; ++j) { va[j] = xr[64 * j]; vb[j] = xr2[64 * j]; }
                float s = 0.f, s2 = 0.f;
#pragma unroll
                for (int j = 0; j < 4; ++j) { s += (va[j].x * va[j].x + va[j].y * va[j].y) + (va[j].z * va[j].z + va[j].w * va[j].w); s2 += (vb[j].x * vb[j].x + vb[j].y * vb[j].y) + (vb[j].z * vb[j].z + vb[j].w * vb[j].w);
                    u32x2 w; w.x = pk2(va[j].x, va[j].y); w.y = pk2(va[j].z, va[j].w); *((u32x2*)(XB + (size_t)m * DM) + lane + 64 * j) = w;
                    w.x = pk2(vb[j].x, vb[j].y); w.y = pk2(vb[j].z, vb[j].w); *((u32x2*)(XB + (size_t)m2 * DM) + lane + 64 * j) = w; }
                s = wave_sum(s); s2 = wave_sum(s2);
                if (lane < 16) { SS[(size_t)m * 16 + lane] = (lane == 0) ? s : 0.f; SS[(size_t)m2 * 16 + lane] = (lane == 0) ? s2 : 0.f; }
            }
            for (int m = gw; m < BATCH * NMEM; m += NGW) {
                const f32x4* xr = (const f32x4*)(a.in[1] + (size_t)m * DM) + lane; f32x4 v[4]; float s = 0.f;
#pragma unroll
                for (int j = 0; j < 4; ++j) { v[j] = xr[64 * j]; s += (v[j].x * v[j].x + v[j].y * v[j].y) + (v[j].z * v[j].z + v[j].w * v[j].w); }
                const float rs = rsqrtf(wave_sum(s) * (1.0f / DM) + EPS);
#pragma unroll
                for (int j = 0; j < 4; ++j) { u32x2 w; w.x = pk2(v[j].x * rs, v[j].y * rs); w.y = pk2(v[j].z * rs, v[j].w * rs); *((u32x2*)(MEMN + (size_t)m * DM) + lane + 64 * j) = w; }
            }
        } else {
            const int l = (ph - 1) / PH_PER_LAYER, sp = (ph - 1) % PH_PER_LAYER;
            const bf16_t* wl = WB + (size_t)l * W_LAYER;
            pg8::StaticOrder SO;
            if (sp == 0 || sp == 11) { if (!(PHMASK & 2)) continue;
                pg8::Gemm g{XB, wl + (sp == 0 ? WO_F1IN : WO_F2IN), M, 5632, 1024, 1024, 1024}; SO.init(M, 5632, G, bx);
                pg8::EpiSwiGLU E{H, SS};
                pg8::gemm_phase(lds, g, SO, E);
                if (sp == 0 && l == 0) {
                    for (int l2 = 0; l2 < NLAYER; ++l2) {
                        pg8::Gemm g2{MEMN, WB + (size_t)l2 * W_LAYER + WO_MKV, BATCH * NMEM, 512, 1024, 1024, 1024}; SO.init(BATCH * NMEM, 512, G, (bx + 128 + 8 * l2) % G);
                        pg8::EpiScale<0> E2{MKV + (size_t)l2 * BATCH * NMEM * 512, 512, nullptr, nullptr};
                        pg8::gemm_phase(lds, g2, SO, E2);
                    }
                }
            } else if (sp == 1 || sp == 12) { if (!(PHMASK & 4)) continue;
                pg8::Gemm g{H, wl + (sp == 1 ? WO_F1OUT : WO_F2OUT), M, 1024, 2816, 2816, 2816}; SO.init(M, 1024, G, bx);
                pg8::EpiResid E{XB, SS, 0.5f};
                pg8::gemm_phase(lds, g, SO, E);
            } else if (sp == 2) { if (!(PHMASK & 8)) continue;
                pg8::Gemm g{XB, wl + WO_MIX, M, ZW, 1024, 1024, 1024}; SO.init(M, ZW, G, bx);
                pg8::EpiScale<1> E{Z, ZW, SS, SSZ};
                pg8::gemm_phase(lds, g, SO, E);
            } else if (sp == 3) { if (!(PHMASK & 16)) continue;
                { pg8::Gemm g{Z, wl + WO_UQ, M, 768, 256, ZW, 256}; SO.init(M, 768, G, bx);
                  pg8::EpiScale<2> E{QR, 768, SSZ, nullptr}; pg8::gemm_phase(lds, g, SO, E); }
                { pg8::Gemm g{Z + 256, wl + WO_UKV, M, 1024, 128, ZW, 128}; SO.init(M, 1024, G, bx);
                  pg8::EpiScale<3> E{KVR, 1024, SSZ, nullptr}; pg8::gemm_phase(lds, g, SO, E); }
            } else if (sp == 4) { if (!(PHMASK & 32)) continue;
                const float* kgain = a.in[12] + l * 96;
                for (int m = gw; m < M; m += NGW) {
                    const int bb = m / SEQ, s = m % SEQ, hh = lane >> 3, sub = lane & 7;
                    float f[16]; float ss = 0.f; float x1[4], x2[4];
                    if (sub < 4) {
                        const u32x4 w0 = *(const u32x4*)(KVR + (size_t)m * 1024 + hh * 128 + sub * 16), w1 = *(const u32x4*)(KVR + (size_t)m * 1024 + hh * 128 + sub * 16 + 8);
                        float t0[8], t1[8]; unpack8(w0, t0); unpack8(w1, t1);
#pragma unroll
                        for (int j = 0; j < 8; ++j) { f[j] = t0[j]; f[8 + j] = t1[j]; ss += t0[j] * t0[j] + t1[j] * t1[j]; }
                    } else {
                        const int i0 = 4 * (sub - 4);
                        const u32x2 wa = *(const u32x2*)(Z + (size_t)m * ZW + 384 + i0), wb = *(const u32x2*)(Z + (size_t)m * ZW + 400 + i0);
                        x1[0] = bf_lo(wa.x); x1[1] = bf_hi(wa.x); x1[2] = bf_lo(wa.y); x1[3] = bf_hi(wa.y);
                        x2[0] = bf_lo(wb.x); x2[1] = bf_hi(wb.x); x2[2] = bf_lo(wb.y); x2[3] = bf_hi(wb.y);
#pragma unroll
                        for (int j = 0; j < 4; ++j) ss += x1[j] * x1[j] + x2[j] * x2[j];
#pragma unroll
                        for (int j = 0; j < 16; ++j) f[j] = 0.f;
                    }
                    ss += __shfl_xor(ss, 1); ss += __shfl_xor(ss, 2); ss += __shfl_xor(ss, 4);
                    const float rs = rsqrtf(ss * (1.0f / 96.0f) + EPS);
                    bf16_t* kdst = KF + ((size_t)(bb * 8 + hh) * SEQ + s) * 96;
                    if (sub < 4) {
                        float o0[8], o1[8];
#pragma unroll
                        for (int j = 0; j < 8; ++j) { o0[j] = f[j] * rs * kgain[sub * 16 + j]; o1[j] = f[8 + j] * rs * kgain[sub * 16 + 8 + j]; }
                        *(u32x4*)(kdst + sub * 16) = pack8(o0); *(u32x4*)(kdst + sub * 16 + 8) = pack8(o1);
                    } else {
                        const int i0 = 4 * (sub - 4); float y1[4], y2[4];
#pragma unroll
                        for (int j = 0; j < 4; ++j) { float c, sn; rope_cs(s, i0 + j, c, sn);
                            const float aa = x1[j] * rs * kgain[64 + i0 + j], bb2 = x2[j] * rs * kgain[80 + i0 + j];
                            y1[j] = aa * c - bb2 * sn; y2[j] = aa * sn + bb2 * c; }
                        u32x2 w; w.x = pk2(y1[0], y1[1]); w.y = pk2(y1[2], y1[3]); *(u32x2*)(kdst + 64 + i0) = w;
                        w.x = pk2(y2[0], y2[1]); w.y = pk2(y2[2], y2[3]); *(u32x2*)(kdst + 80 + i0) = w;
                    }
                }
            } else if (sp == 5) { if (!(PHMASK & 64)) continue;
                { AttnP P{QR, 768, 0, KF, KVR, OB, 1024, 0, a.in[11] + l * 96, nullptr, nullptr, nullptr, SSZ, 0};
                  const float* qgp = a.in[11] + l * 96; const float* kgp = a.in[12] + l * 96;
                  float gq = fmaxf(fabsf(qgp[lane]), (lane < 32) ? fabsf(qgp[64 + lane]) : 0.f), gk = fmaxf(fabsf(kgp[lane]), (lane < 32) ? fabsf(kgp[64 + lane]) : 0.f);
#pragma unroll
                  for (int o = 1; o < 64; o <<= 1) { gq = fmaxf(gq, __shfl_xor(gq, o)); gk = fmaxf(gk, __shfl_xor(gk, o)); }
                  const float Bnd = 9.797958971f * LOG2E * 1.02f * gq * gk;
                  if (G == 256 && Bnd <= 20.0f) {
                      for (int i = 0; i < 4; ++i) { const int bh = (vcu >> 5) * 4 + i, qb = vcu & 31; mla_unit_fast(P, bh >> 3, bh & 7, qb, lds); }
                  } else if (G == 256) {
                      for (int i = 0; i < 4; ++i) { const int bh = (vcu >> 5) * 4 + i, qb = vcu & 31; mla_unit(P, bh >> 3, bh & 7, qb, lds); }
                  } else {
                      for (int U = vcu; U < 1024; U += G) { const int bh = (U & 255) >> 3, qb = (U & 7) | ((U >> 8) << 3); mla_unit(P, bh >> 3, bh & 7, qb, lds); }
                  } }
#ifndef ONLY_MLA
                { AttnP P{Z, ZW, 512, Z + 768, Z + 896, OB, 1024, 512, a.in[13] + l * 64, a.in[14] + l * 64, a.in[15] + l * 4, nullptr, SSZ, 8};
                  for (int U = vcu; U < 512; U += G) attn_unit<AT_SWA>(P, U >> 7, (U >> 5) & 3, U & 31, lds); }
                { AttnP P{Z, ZW, 1024, Z + 1280, Z + 1536, OB, 1024, 768, a.in[16] + l * 64, a.in[17] + l * 64, nullptr, a.in[18] + (size_t)l * 4 * 465, SSZ, 12};
                  for (int U = vcu; U < 512; U += G) attn_unit<AT_NA>(P, U >> 7, (U >> 5) & 3, U & 31, lds); }
#endif
            } else if (sp == 6) {
            } else if (sp == 7) { if (!(PHMASK & 256)) continue;
                pg8::Gemm g{OB, wl + WO_MO, M, 1024, 1024, 1024, 1024}; SO.init(M, 1024, G, bx);
                pg8::EpiResidKS E{XB, SS, 1.0f, SSZ};
                pg8::gemm_phase(lds, g, SO, E);
            } else if (sp == 8) { if (!(PHMASK & 512)) continue;
                pg8::Gemm g{XB, wl + WO_MQ, M, 256, 1024, 1024, 1024}; SO.init(M, 256, G, bx);
                pg8::EpiScale<1> E{QM, 256, SS, nullptr};
                pg8::gemm_phase(lds, g, SO, E);
            } else if (sp == 9) { if (!(PHMASK & 1024)) continue;
                const bf16_t* mkv = MKV + (size_t)l * BATCH * NMEM * 512;
                AttnP P{QM, 256, 0, mkv, mkv, OM, 256, 0, a.in[25] + l * 64, a.in[26] + l * 64, nullptr, nullptr, nullptr, 0};
                for (int U = vcu; U < 512; U += G) attn_unit<AT_MEM>(P, U >> 7, (U >> 5) & 3, U & 31, lds);
            } else if (sp == 10) { if (!(PHMASK & 2048)) continue;
                pg8::Gemm g{OM, wl + WO_MOUT, M, 1024, 256, 256, 256}; SO.init(M, 1024, G, bx);
                pg8::EpiResid E{XB, SS, 1.0f};
                pg8::gemm_phase(lds, g, SO, E);
            } else if (sp == 13) {
                const float* gn = a.in[31] + l * 1024; const bool lastl = (l == NLAYER - 1);
                const f32x4 g0 = *(const f32x4*)(gn + lane * 16), g1 = *(const f32x4*)(gn + lane * 16 + 4), g2 = *(const f32x4*)(gn + lane * 16 + 8), g3 = *(const f32x4*)(gn + lane * 16 + 12);
                for (int m = gw; m < M; m += 4 * NGW) {
                    u32x4 w[4][2];
#pragma unroll
                    for (int r = 0; r < 4; ++r) { const int mr = (m + r * NGW < M) ? m + r * NGW : m; const bf16_t* xrow = XB + (size_t)mr * DM + lane * 16;
                        w[r][0] = *(const u32x4*)xrow; w[r][1] = *(const u32x4*)(xrow + 8); }
#pragma unroll
                    for (int r = 0; r < 4; ++r) { if (r > 0 && m + r * NGW >= M) continue; const int mr = m + r * NGW; bf16_t* xrow = XB + (size_t)mr * DM + lane * 16;
                        float t0[8], t1[8]; unpack8(w[r][0], t0); unpack8(w[r][1], t1); float s = 0.f;
#pragma unroll
                        for (int j = 0; j < 8; ++j) s += t0[j] * t0[j] + t1[j] * t1[j];
                        const float rs = rsqrtf(wave_sum(s) * (1.0f / DM) + EPS); float s2 = 0.f;
#pragma unroll
                        for (int j = 0; j < 4; ++j) { t0[j] *= rs * g0[j]; t0[4 + j] *= rs * g1[j]; t1[j] *= rs * g2[j]; t1[4 + j] *= rs * g3[j]; }
#pragma unroll
                        for (int j = 0; j < 8; ++j) s2 += t0[j] * t0[j] + t1[j] * t1[j];
                        if (lastl) {
                            float* orow = XR + (size_t)mr * DM + lane * 16;
                            *(f32x4*)orow = (f32x4){t0[0], t0[1], t0[2], t0[3]}; *(f32x4*)(orow + 4) = (f32x4){t0[4], t0[5], t0[6], t0[7]};
                            *(f32x4*)(orow + 8) = (f32x4){t1[0], t1[1], t1[2], t1[3]}; *(f32x4*)(orow + 12) = (f32x4){t1[4], t1[5], t1[6], t1[7]};
                        } else {
                            *(u32x4*)xrow = pack8(t0); *(u32x4*)(xrow + 8) = pack8(t1);
                            s2 = wave_sum(s2);
                            if (lane < 16) SS[(size_t)mr * 16 + lane] = (lane == 0) ? s2 : 0.f;
                        } }
                }
            }
        }
#if !MK_PER_PHASE
        if (ph + 1 < ph_hi && !(ph > 0 && (ph - 1) % PH_PER_LAYER == 6)) xcd_barrier(gbar);
#endif
    }
}

extern "C" void kernel_launch(void* const* d_in, const int* in_sizes, int n_in, void* d_out, int out_size, void* d_ws, size_t ws_size, hipStream_t stream) {
    static int grid = 0;
    if (grid == 0) {
        if (n_in != 32 || out_size != M * DM || ws_size < WS_END) { fprintf(stderr, "kernel_launch: unexpected shapes (n_in %d, out %d, ws %zu)\n", n_in, out_size, ws_size); grid = -1; return; }
        int dev = 0, cus = 0, per_cu = 0;
        hipGetDevice(&dev);
        hipDeviceGetAttribute(&cus, hipDeviceAttributeMultiprocessorCount, dev);
        hipFuncSetAttribute((const void*)mk_fwd, hipFuncAttributeMaxDynamicSharedMemorySize, LDS_BYTES);
        hipOccupancyMaxActiveBlocksPerMultiprocessor(&per_cu, (const void*)mk_fwd, 512, LDS_BYTES);
        if (per_cu < 1) { fprintf(stderr, "kernel_launch: occupancy query gave %d\n", per_cu); per_cu = 1; }
        (void)hipGetLastError();
        grid = cus * per_cu;
    }
    if (grid < 0) return;
    if (hipMemsetAsync((char*)d_ws + WS_CTL, 0, CTL_BYTES, stream) != hipSuccess) { fprintf(stderr, "kernel_launch: memset of barrier words failed\n"); return; }
    Args a{};
    for (int i = 0; i < 32; ++i) a.in[i] = (const float*)d_in[i];
    a.out = (float*)d_out; a.ws = (unsigned char*)d_ws;
#if MK_PER_PHASE
    for (int ph = 0; ph < N_PHASES; ++ph) { a.ph_lo = ph; a.ph_hi = ph + 1; hipLaunchKernelGGL(mk_fwd, dim3(grid), dim3(512), LDS_BYTES, stream, a); }
#else
    a.ph_lo = 0; a.ph_hi = N_PHASES;
    void* args[] = {&a};
    hipError_t e = hipLaunchCooperativeKernel((const void*)mk_fwd, dim3(grid), dim3(512), args, LDS_BYTES, stream);
    if (e != hipSuccess) fprintf(stderr, "cooperative launch failed: %s (grid %d)\n", hipGetErrorString(e), grid);
#endif
}
```
